# Optimizing an MI355X kernel written in HIP

```python
import jax, jax.numpy as jnp
from jax import lax
import numpy as np


D_MODEL = 1024
BATCH = 4
SEQ = 4096
DEPTH = 1

CHUNK = 64
MIX_WIDTH = D_MODEL
RET_HEAD_DIM = D_MODEL // 8
RET_HEADS = 4
RET_WIDTH = RET_HEADS * RET_HEAD_DIM
CONV_WIDTH = MIX_WIDTH - RET_WIDTH
CONV_K = 3
D_FF = ((8 * D_MODEL + 3 * 256 - 1) // (3 * 256)) * 256
IN_COLS = 4 * RET_WIDTH + 3 * CONV_WIDTH
ROPE_BASE = 10000.0
NORM_EPS = 1e-6

kernel_name = 'hybrid_retention_shortconv_block'


def rmsnorm(x, g):
    xf = x.astype(jnp.float32)
    y = xf * lax.rsqrt(jnp.mean(xf * xf, axis=-1, keepdims=True) + NORM_EPS)
    return (y * g.astype(jnp.float32)).astype(x.dtype)


def rotary(t, pos):
    d = t.shape[-1]
    inv_freq = 1.0 / (ROPE_BASE ** (jnp.arange(0, d, 2, dtype=jnp.float32) / d))
    ang = pos[:, None] * inv_freq[None, :]
    cos = jnp.cos(ang)[None, :, None, :]
    sin = jnp.sin(ang)[None, :, None, :]
    t1, t2 = t[..., : d // 2], t[..., d // 2:]
    return jnp.concatenate([t1 * cos - t2 * sin, t1 * sin + t2 * cos], axis=-1)


def chunk_retention(q, k, v):
    b, s, h, dk = q.shape
    dv = v.shape[-1]
    nc = s // CHUNK
    log_g = jnp.log1p(-jnp.exp2(-5.0 - jnp.arange(h, dtype=jnp.float32)))
    idx = jnp.arange(CHUNK, dtype=jnp.float32)
    dist = jnp.abs(idx[:, None] - idx[None, :])
    decay_intra = jnp.exp(log_g[:, None, None] * dist)
    xi = jnp.exp(log_g[:, None] * (idx[None, :] + 1.0))
    zeta = jnp.exp(log_g[:, None] * (CHUNK - 1.0 - idx[None, :]))
    chunk_decay = jnp.exp(log_g * CHUNK)

    qc = q.reshape(b, nc, CHUNK, h, dk)
    kc = k.reshape(b, nc, CHUNK, h, dk)
    vc = v.reshape(b, nc, CHUNK, h, dv)

    scores = jnp.einsum('bnihd,bnjhd->bnhij', qc, kc) * decay_intra[None, None]
    intra = jnp.einsum('bnhij,bnjhe->bnihe', scores, vc)

    incr = jnp.einsum('bnjhd,hj,bnjhe->nbhde', kc, zeta, vc)

    def step(state, u):
        return chunk_decay[None, :, None, None] * state + u, state

    _, state_prev = lax.scan(step, jnp.zeros((b, h, dk, dv), jnp.float32), incr)
    cross = jnp.einsum('bnihd,hi,nbhde->bnihe', qc, xi, state_prev)
    return (intra + cross).reshape(b, s, h, dv)


def causal_depthwise_conv(u, w):
    s = u.shape[1]
    up = jnp.pad(u, ((0, 0), (CONV_K - 1, 0), (0, 0)))
    out = w[0] * up[:, 0:s]
    for tap in range(1, CONV_K):
        out = out + w[tap] * up[:, tap:tap + s]
    return out


def setup_inputs(seed: int = 0) -> dict:
    key = jax.random.key(seed)
    ks = jax.random.split(key, 11)
    f32 = jnp.float32
    def nrm(k, shape, scale):
        return jax.random.normal(k, shape, f32) * scale
    return {
        'x': nrm(ks[0], (BATCH, SEQ, D_MODEL), 1.0),
        'norm1_w': 1.0 + nrm(ks[1], (DEPTH, D_MODEL), 0.02),
        'w_in': nrm(ks[2], (DEPTH, D_MODEL, IN_COLS), D_MODEL ** -0.5),
        'w_conv': nrm(ks[3], (DEPTH, CONV_K, CONV_WIDTH), CONV_K ** -0.5),
        'ret_gn_w': 1.0 + nrm(ks[4], (DEPTH, RET_WIDTH), 0.02),
        'w_o': nrm(ks[5], (DEPTH, MIX_WIDTH, D_MODEL), MIX_WIDTH ** -0.5),
        'norm2_w': 1.0 + nrm(ks[6], (DEPTH, D_MODEL), 0.02),
        'w_gate': nrm(ks[7], (DEPTH, D_MODEL, D_FF), D_MODEL ** -0.5),
        'w_up': nrm(ks[8], (DEPTH, D_MODEL, D_FF), D_MODEL ** -0.5),
        'w_down': nrm(ks[9], (DEPTH, D_FF, D_MODEL), D_FF ** -0.5),
        'final_norm_w': 1.0 + nrm(ks[10], (D_MODEL,), 0.02),
    }


def reference(x, norm1_w, w_in, w_conv, ret_gn_w, w_o, norm2_w, w_gate, w_up, w_down, final_norm_w):
    b, s, _ = x.shape
    dt = x.dtype
    pos = jnp.arange(s, dtype=jnp.float32)
    split_at = [RET_WIDTH, 2 * RET_WIDTH, 3 * RET_WIDTH, 4 * RET_WIDTH,
                4 * RET_WIDTH + CONV_WIDTH, 4 * RET_WIDTH + 2 * CONV_WIDTH]
    for layer in range(DEPTH):
        h = rmsnorm(x, norm1_w[layer])
        proj = h @ w_in[layer]
        q, k, v, g, cb, cc, ch = jnp.split(proj, split_at, axis=-1)

        qh = q.astype(jnp.float32).reshape(b, s, RET_HEADS, RET_HEAD_DIM)
        kh = k.astype(jnp.float32).reshape(b, s, RET_HEADS, RET_HEAD_DIM)
        vh = v.astype(jnp.float32).reshape(b, s, RET_HEADS, RET_HEAD_DIM)
        qh = rotary(qh, pos) * (RET_HEAD_DIM ** -0.5)
        kh = rotary(kh, pos)
        r = chunk_retention(qh, kh, vh)
        r = r * lax.rsqrt(jnp.mean(r * r, axis=-1, keepdims=True) + NORM_EPS)
        r = r.reshape(b, s, RET_WIDTH) * ret_gn_w[layer].astype(jnp.float32)
        ret_out = (r * jax.nn.silu(g.astype(jnp.float32))).astype(dt)

        conv_out = cb * causal_depthwise_conv(cc * ch, w_conv[layer])

        mix = jnp.concatenate([ret_out, conv_out], axis=-1)
        x = x + mix @ w_o[layer]

        h2 = rmsnorm(x, norm2_w[layer])
        x = x + (jax.nn.silu(h2 @ w_gate[layer]) * (h2 @ w_up[layer])) @ w_down[layer]
    return rmsnorm(x, final_norm_w)
```

```cpp
#include <hip/hip_runtime.h>
#include <hip/hip_cooperative_groups.h>
#include <cstdio>
#include <cstdint>
namespace cg = cooperative_groups;
namespace pg8 {
#define PG8_LAS __attribute__((address_space(3)))
typedef unsigned short bf16_t;
typedef short bf16x8 __attribute__((ext_vector_type(8)));
typedef float f32x4 __attribute__((ext_vector_type(4)));
typedef unsigned u32x4 __attribute__((ext_vector_type(4)));
constexpr int BM = 256, BK = 64, HALF = 128, HTB = HALF * BK * 2  , STAGE_BYTES = 8 * HTB, NXCD = 8, WGM = 8;

__host__ __device__ __forceinline__ int lds_byte(int r, int c) { const int st = (r >> 4) * 2 + (c >> 5), rr = r & 15, cc = c & 31, ob = rr * 64 + cc * 2; return st * 1024 + (ob ^ (((ob >> 9) & 1) << 5)); }
__host__ __device__ __forceinline__ void stage_rc(int b, int& R, int& C) { const int st = b / 1024, sb = b % 1024, swz = sb ^ (((sb >> 9) & 1) << 5); R = (st >> 1) * 16 + swz / 64; C = (st & 1) * 32 + (swz % 64) / 2; }
__host__ __device__ __forceinline__ int perm32(int rho) { const int n = rho >> 4, i = rho & 15; return 8 * (i >> 2) + 4 * n + (i & 3); }

struct Unit { int pm, pn; };
struct Gemm { const bf16_t* A; const bf16_t* Bt; int M, N, K; };

struct StaticOrder {
    int nM, nN, nwg, G, c;
    __host__ __device__ void init(int M, int N, int G_, int c_) { nM = M / BM; nN = N / BM; nwg = nM * nN; G = G_; c = c_; }
    __host__ __device__ bool next(int i, Unit& u) const {
        const long L = (long)i * G + c; if (L >= nwg) return false;
        int wgid = (int)L; { const int q = nwg / NXCD, r = nwg % NXCD, xcd = wgid % NXCD, off = wgid / NXCD; wgid = (xcd < r ? xcd * (q + 1) : r * (q + 1) + (xcd - r) * q) + off; }
        const int nig = WGM * nN, gid = wgid / nig, fm = gid * WGM, gsz = (nM - fm) < WGM ? (nM - fm) : WGM;
        u.pm = fm + ((wgid % nig) % gsz); u.pn = (wgid % nig) / gsz; return true;
    }
    __device__ __forceinline__ void a_ready(const Unit&) const {}
    __device__ __forceinline__ void done(const Unit&) const {}
};


typedef float f32x2_t __attribute__((ext_vector_type(2))); typedef __bf16 bf16x2_t __attribute__((ext_vector_type(2)));
__device__ __forceinline__ unsigned cvt_pk_bf16(float lo, float hi) { f32x2_t v = {lo, hi}; bf16x2_t b = __builtin_convertvector(v, bf16x2_t); return __builtin_bit_cast(unsigned, b); }

struct EpiProj {
    static constexpr bool PERM = true, AFTER_DRAIN = false;
    bf16_t* O; const float* costab; const float* sintab;
    __device__ __forceinline__ void operator()(const f32x4 (&acc)[2][2][4][2], const Unit& u, int wr, int wc, int fr, int fq) const {
        const int row0 = u.pm * BM + wr * 64 + fr, col0 = u.pn * BM + wc * 32 + 8 * fq;
        if (u.pn < 4) {
            const float sc = (u.pn < 2) ? 0.08838834764831845f : 1.0f;
            const int dd0 = (wc & 1) * 32 + 8 * fq;
#pragma unroll
            for (int ai = 0; ai < 2; ++ai)
#pragma unroll
                for (int m = 0; m < 4; ++m) {
                    const int row = row0 + ai * HALF + m * 16, pos = row & 4095;
                    const f32x4 c0 = *(const f32x4*)(costab + pos * 64 + dd0), c1 = *(const f32x4*)(costab + pos * 64 + dd0 + 4);
                    const f32x4 s0 = *(const f32x4*)(sintab + pos * 64 + dd0), s1 = *(const f32x4*)(sintab + pos * 64 + dd0 + 4);
                    const f32x4 a0 = acc[ai][0][m][0], a1 = acc[ai][0][m][1], b0 = acc[ai][1][m][0], b1 = acc[ai][1][m][1];
                    const f32x4 o10 = (a0 * c0 - b0 * s0) * sc, o11 = (a1 * c1 - b1 * s1) * sc, o20 = (a0 * s0 + b0 * c0) * sc, o21 = (a1 * s1 + b1 * c1) * sc;
                    bf16_t* rowp = O + (size_t)row * 3584 + col0;
                    u32x4 w; w.x = cvt_pk_bf16(o10[0], o10[1]); w.y = cvt_pk_bf16(o10[2], o10[3]); w.z = cvt_pk_bf16(o11[0], o11[1]); w.w = cvt_pk_bf16(o11[2], o11[3]);
                    *(u32x4*)rowp = w;
                    w.x = cvt_pk_bf16(o20[0], o20[1]); w.y = cvt_pk_bf16(o20[2], o20[3]); w.z = cvt_pk_bf16(o21[0], o21[1]); w.w = cvt_pk_bf16(o21[2], o21[3]);
                    *(u32x4*)(rowp + HALF) = w;
                }
        } else {
#pragma unroll
            for (int ai = 0; ai < 2; ++ai)
#pragma unroll
                for (int m = 0; m < 4; ++m) { bf16_t* rowp = O + (size_t)(row0 + ai * HALF + m * 16) * 3584 + col0;
#pragma unroll
                    for (int bj = 0; bj < 2; ++bj) { const f32x4 v0 = acc[ai][bj][m][0], v1 = acc[ai][bj][m][1];
                        u32x4 w; w.x = cvt_pk_bf16(v0[0], v0[1]); w.y = cvt_pk_bf16(v0[2], v0[3]); w.z = cvt_pk_bf16(v1[0], v1[1]); w.w = cvt_pk_bf16(v1[2], v1[3]);
                        *(u32x4*)(rowp + bj * HALF) = w; } }
        }
    }
};
struct EpiRes1 {
    static constexpr bool PERM = true, AFTER_DRAIN = false;
    const float* x; float* out; bf16_t* xb; float* rowss;
    __device__ __forceinline__ void operator()(const f32x4 (&acc)[2][2][4][2], const Unit& u, int wr, int wc, int fr, int fq) const {
        const int row0 = u.pm * BM + wr * 64 + fr, col0 = u.pn * BM + wc * 32 + 8 * fq;
#pragma unroll
        for (int ai = 0; ai < 2; ++ai)
#pragma unroll
            for (int m = 0; m < 4; ++m) { const int row = row0 + ai * HALF + m * 16; const size_t off = (size_t)row * 1024 + col0; float ss = 0.f;
#pragma unroll
                for (int bj = 0; bj < 2; ++bj) {
                    const f32x4 v0 = acc[ai][bj][m][0] + *(const f32x4*)(x + off + bj * HALF), v1 = acc[ai][bj][m][1] + *(const f32x4*)(x + off + bj * HALF + 4);
                    *(f32x4*)(out + off + bj * HALF) = v0; *(f32x4*)(out + off + bj * HALF + 4) = v1;
                    u32x4 w; w.x = cvt_pk_bf16(v0[0], v0[1]); w.y = cvt_pk_bf16(v0[2], v0[3]); w.z = cvt_pk_bf16(v1[0], v1[1]); w.w = cvt_pk_bf16(v1[2], v1[3]);
                    *(u32x4*)(xb + off + bj * HALF) = w;
                    ss += (v0[0] * v0[0] + v0[1] * v0[1]) + (v0[2] * v0[2] + v0[3] * v0[3]) + (v1[0] * v1[0] + v1[1] * v1[1]) + (v1[2] * v1[2] + v1[3] * v1[3]); }
                ss += __shfl_xor(ss, 16); ss += __shfl_xor(ss, 32);
                if (fq == 0) (void)__hip_atomic_fetch_add(rowss + row, ss, __ATOMIC_RELAXED, __HIP_MEMORY_SCOPE_AGENT); }
    }
};
struct EpiGU {
    static constexpr bool PERM = true, AFTER_DRAIN = false;
    bf16_t* Hh; const float* rowss;
    __device__ __forceinline__ void operator()(const f32x4 (&acc)[2][2][4][2], const Unit& u, int wr, int wc, int fr, int fq) const {
        const int row0 = u.pm * BM + wr * 64 + fr, col0 = u.pn * HALF + wc * 32 + 8 * fq;
#pragma unroll
        for (int ai = 0; ai < 2; ++ai)
#pragma unroll
            for (int m = 0; m < 4; ++m) { const int row = row0 + ai * HALF + m * 16;
                const float rstd = __builtin_amdgcn_rsqf(rowss[row] * (1.0f / 1024.0f) + 1e-6f);
                unsigned w[4];
#pragma unroll
                for (int n = 0; n < 2; ++n) { const f32x4 g = acc[ai][0][m][n] * rstd, up = acc[ai][1][m][n] * rstd; float o[4];
#pragma unroll
                    for (int j = 0; j < 4; ++j) o[j] = g[j] * __builtin_amdgcn_rcpf(1.0f + __builtin_amdgcn_exp2f(g[j] * -1.4426950408889634f)) * up[j];
                    w[2 * n] = cvt_pk_bf16(o[0], o[1]); w[2 * n + 1] = cvt_pk_bf16(o[2], o[3]); }
                *(u32x4*)(Hh + (size_t)row * 2816 + col0) = (u32x4){w[0], w[1], w[2], w[3]}; }
    }
};
struct EpiRes2 {
    static constexpr bool PERM = true, AFTER_DRAIN = false;
    float* out;
    __device__ __forceinline__ void operator()(const f32x4 (&acc)[2][2][4][2], const Unit& u, int wr, int wc, int fr, int fq) const {
        const int row0 = u.pm * BM + wr * 64 + fr, col0 = u.pn * BM + wc * 32 + 8 * fq;
#pragma unroll
        for (int ai = 0; ai < 2; ++ai)
#pragma unroll
            for (int m = 0; m < 4; ++m) { const size_t off = (size_t)(row0 + ai * HALF + m * 16) * 1024 + col0;
#pragma unroll
                for (int bj = 0; bj < 2; ++bj) {
                    const f32x4 v0 = acc[ai][bj][m][0] + *(const f32x4*)(out + off + bj * HALF), v1 = acc[ai][bj][m][1] + *(const f32x4*)(out + off + bj * HALF + 4);
                    *(f32x4*)(out + off + bj * HALF) = v0; *(f32x4*)(out + off + bj * HALF + 4) = v1; } }
    }
};

template <class Epi, class Sched, bool ALIGN_EPI = false, bool SP2 = false>
__device__ __forceinline__ void gemm_phase(PG8_LAS unsigned char* lds, const Gemm g, const Sched& S, const Epi& E) {
    const int tid = threadIdx.x, wid = __builtin_amdgcn_readfirstlane(tid >> 6), lane = tid & 63, wr = wid >> 2, wc = wid & 3, fr = lane & 15, fq = lane >> 4;
    const int K = g.K, nt = K / BK;
    unsigned voffA[2], voffB[2];
#pragma unroll
    for (int i = 0; i < 2; ++i) { int R, C; stage_rc(tid * 16 + i * 8192, R, C); const int Rb = Epi::PERM ? ((R & ~31) + perm32(R & 31)) : R;
        voffA[i] = (unsigned)(R * K + C) * 2u; voffB[i] = (unsigned)(Rb * K + C) * 2u; }
    const size_t kstep = (size_t)(BK * 2);
    const size_t hstep = (size_t)HALF * K * 2;
    const size_t tstep = 2 * hstep;
    const unsigned ldsw = (unsigned)wid * 1024u;
    const int aoff = lds_byte(wr * 64 + fr, fq * 8), boff = lds_byte(wc * 32 + fr, fq * 8);
#define PG8_SA(b, h) (((b) * 2 + (h)) * HTB)
#define PG8_SB(b, h) ((4 + (b) * 2 + (h)) * HTB)
#define PG8_STAGE(bufoff, gbase, voff) do { _Pragma("unroll") for (int _i = 0; _i < 2; ++_i) \
        __builtin_amdgcn_global_load_lds((const unsigned*)((const char*)(gbase) + (voff)[_i]), (PG8_LAS unsigned*)(lds + (bufoff) + ldsw + _i * 8192), 16, 0, 0); } while (0)
#define PG8_LDA(dst, b, h) do { _Pragma("unroll") for (int m = 0; m < 4; ++m) _Pragma("unroll") for (int k = 0; k < 2; ++k) dst[m][k] = *(const PG8_LAS bf16x8*)(lds + PG8_SA(b, h) + aoff + m * 2048 + k * 1024); } while (0)
#define PG8_LDB(dst, b, h) do { _Pragma("unroll") for (int n = 0; n < 2; ++n) _Pragma("unroll") for (int k = 0; k < 2; ++k) dst[n][k] = *(const PG8_LAS bf16x8*)(lds + PG8_SB(b, h) + boff + n * 2048 + k * 1024); } while (0)
#define PG8_MMA(ai, bj, At, Bt) do { __builtin_amdgcn_s_setprio(1); _Pragma("unroll") for (int m = 0; m < 4; ++m) _Pragma("unroll") for (int n = 0; n < 2; ++n) _Pragma("unroll") for (int k = 0; k < 2; ++k) \
        acc[ai][bj][m][n] = __builtin_amdgcn_mfma_f32_16x16x32_bf16(Bt[n][k], At[m][k], acc[ai][bj][m][n], 0, 0, 0); __builtin_amdgcn_s_setprio(0); } while (0)
#define PG8_WAIT_V(n) asm volatile("s_waitcnt vmcnt(" #n ")" ::: "memory")
#define PG8_WAIT_L(n) asm volatile("s_waitcnt lgkmcnt(" #n ")" ::: "memory")
#define PG8_BAR __builtin_amdgcn_s_barrier()
#define PG8_SCHED __builtin_amdgcn_sched_barrier(0)
    Unit cur, nxt; int ui = 0;
    if (!S.next(0, cur)) return;
    f32x4 acc[2][2][4][2];
#pragma unroll
    for (int a = 0; a < 2; ++a)
#pragma unroll
        for (int b = 0; b < 2; ++b)
#pragma unroll
            for (int m = 0; m < 4; ++m)
#pragma unroll
                for (int n = 0; n < 2; ++n) acc[a][b][m][n] = (f32x4){0.f, 0.f, 0.f, 0.f};
    bf16x8 At[4][2], B0[2][2], B1[2][2];
    const char* cA = (const char*)g.A + (size_t)cur.pm * tstep; const char* cB = (const char*)g.Bt + (size_t)cur.pn * tstep;
    S.a_ready(cur);
    if constexpr (SP2) {
        PG8_STAGE(PG8_SB(0, 0), cB, voffB); PG8_STAGE(PG8_SB(0, 1), cB + hstep, voffB); PG8_STAGE(PG8_SA(0, 0), cA, voffA); PG8_STAGE(PG8_SA(0, 1), cA + hstep, voffA);
        if (wr == 1) PG8_BAR;
        PG8_WAIT_V(2); PG8_BAR;
        PG8_STAGE(PG8_SB(1, 0), cB + kstep, voffB); PG8_STAGE(PG8_SA(1, 0), cA + kstep, voffA); PG8_STAGE(PG8_SB(1, 1), cB + hstep + kstep, voffB);
        PG8_WAIT_V(6); PG8_BAR;
    } else {
        PG8_STAGE(PG8_SB(0, 0), cB, voffB); PG8_STAGE(PG8_SA(0, 0), cA, voffA); PG8_STAGE(PG8_SB(0, 1), cB + hstep, voffB); PG8_STAGE(PG8_SA(0, 1), cA + hstep, voffA);
        if (wr == 1) PG8_BAR;
        PG8_WAIT_V(4); PG8_BAR;
        PG8_STAGE(PG8_SB(1, 0), cB + kstep, voffB); PG8_STAGE(PG8_SA(1, 0), cA + kstep, voffA); PG8_STAGE(PG8_SB(1, 1), cB + hstep + kstep, voffB);
        PG8_WAIT_V(6); PG8_BAR;
    }
    for (;;) {
        const bool has_next = S.next(ui + 1, nxt);
        const char* nA = has_next ? (const char*)g.A + (size_t)nxt.pm * tstep : cA; const char* nB = has_next ? (const char*)g.Bt + (size_t)nxt.pn * tstep : cB;
        for (int t = 0; t < nt; t += 2) {
            const bool last = (t == nt - 2);
            const char* a1 = cA + (size_t)(t + 1) * kstep;
            const char* a2 = last ? nA : cA + (size_t)(t + 2) * kstep; const char* b2 = last ? nB : cB + (size_t)(t + 2) * kstep;
            const char* a3 = a2 + kstep; const char* b3 = b2 + kstep;
            if (last && has_next) S.a_ready(nxt);
            if constexpr (SP2) {
            PG8_LDB(B0, 0, 0); PG8_LDB(B1, 0, 1); PG8_SCHED; PG8_LDA(At, 0, 0); PG8_STAGE(PG8_SA(1, 1), a1 + hstep, voffA);
            PG8_WAIT_V(8); PG8_WAIT_L(0); PG8_BAR; PG8_MMA(0, 0, At, B0); PG8_MMA(0, 1, At, B1); PG8_BAR; PG8_SCHED;
            PG8_LDA(At, 0, 1); PG8_STAGE(PG8_SB(0, 0), b2, voffB); PG8_STAGE(PG8_SB(0, 1), b2 + hstep, voffB); PG8_STAGE(PG8_SA(0, 0), a2, voffA);
            PG8_WAIT_V(8); PG8_WAIT_L(0); PG8_BAR; PG8_MMA(1, 0, At, B0); PG8_MMA(1, 1, At, B1); PG8_BAR; PG8_SCHED;
            PG8_LDB(B0, 1, 0); PG8_LDB(B1, 1, 1); PG8_SCHED; PG8_LDA(At, 1, 0); PG8_STAGE(PG8_SA(0, 1), a2 + hstep, voffA);
            PG8_WAIT_V(8); PG8_WAIT_L(0); PG8_BAR; PG8_MMA(0, 0, At, B0); PG8_MMA(0, 1, At, B1); PG8_BAR; PG8_SCHED;
            PG8_LDA(At, 1, 1); PG8_STAGE(PG8_SB(1, 0), b3, voffB); PG8_STAGE(PG8_SB(1, 1), b3 + hstep, voffB); PG8_STAGE(PG8_SA(1, 0), a3, voffA);
            PG8_WAIT_V(8); PG8_WAIT_L(0); PG8_BAR; PG8_MMA(1, 0, At, B0); PG8_MMA(1, 1, At, B1); PG8_BAR; PG8_SCHED;
            } else {
            PG8_LDB(B0, 0, 0); PG8_SCHED; PG8_LDA(At, 0, 0); PG8_STAGE(PG8_SA(1, 1), a1 + hstep, voffA);
            PG8_WAIT_L(8); PG8_BAR; PG8_WAIT_L(0); PG8_MMA(0, 0, At, B0); PG8_BAR; PG8_SCHED;
            PG8_LDB(B1, 0, 1); PG8_STAGE(PG8_SB(0, 0), b2, voffB);
            PG8_BAR; PG8_WAIT_L(0); PG8_MMA(0, 1, At, B1); PG8_BAR;
            PG8_LDA(At, 0, 1); PG8_STAGE(PG8_SA(0, 0), a2, voffA);
            PG8_BAR; PG8_WAIT_L(0); PG8_MMA(1, 0, At, B0); PG8_BAR; PG8_SCHED;
            PG8_STAGE(PG8_SB(0, 1), b2 + hstep, voffB);
            PG8_WAIT_V(6); PG8_BAR; PG8_MMA(1, 1, At, B1); PG8_BAR;
            PG8_LDB(B0, 1, 0); PG8_SCHED; PG8_LDA(At, 1, 0); PG8_STAGE(PG8_SA(0, 1), a2 + hstep, voffA);
            PG8_WAIT_L(8); PG8_BAR; PG8_WAIT_L(0); PG8_MMA(0, 0, At, B0); PG8_BAR; PG8_SCHED;
            PG8_LDB(B1, 1, 1); PG8_STAGE(PG8_SB(1, 0), b3, voffB);
            PG8_BAR; PG8_WAIT_L(0); PG8_MMA(0, 1, At, B1); PG8_BAR;
            PG8_LDA(At, 1, 1); PG8_STAGE(PG8_SA(1, 0), a3, voffA);
            PG8_BAR; PG8_WAIT_L(0); PG8_MMA(1, 0, At, B0); PG8_BAR; PG8_SCHED;
            PG8_STAGE(PG8_SB(1, 1), b3 + hstep, voffB);
            PG8_WAIT_V(6); PG8_BAR; PG8_MMA(1, 1, At, B1); PG8_BAR;
            }
        }
        if constexpr (ALIGN_EPI) { if (wr == 0) PG8_BAR; }
        if constexpr (!Epi::AFTER_DRAIN) { E(acc, cur, wr, wc, fr, fq); S.done(cur); }
        if (!has_next) break;
#pragma unroll
        for (int a = 0; a < 2; ++a)
#pragma unroll
            for (int b = 0; b < 2; ++b)
#pragma unroll
                for (int m = 0; m < 4; ++m)
#pragma unroll
                    for (int n = 0; n < 2; ++n) acc[a][b][m][n] = (f32x4){0.f, 0.f, 0.f, 0.f};
        cur = nxt; cA = nA; cB = nB; ++ui;
        if constexpr (ALIGN_EPI) { if (wr == 1) PG8_BAR; }
    }
    PG8_WAIT_V(0);
    if constexpr (!ALIGN_EPI) { if (wr == 0) PG8_BAR; }
    PG8_BAR;
    if constexpr (Epi::AFTER_DRAIN) { E.fused(acc, cur, wr, wc, fr, fq, lds, wid, lane); S.done(cur); }
#undef PG8_SA
#undef PG8_SB
#undef PG8_STAGE
#undef PG8_LDA
#undef PG8_LDB
#undef PG8_MMA
#undef PG8_WAIT_V
#undef PG8_WAIT_L
#undef PG8_BAR
#undef PG8_SCHED
}
}

#define PG8_SP2 true
#define PG8_ALIGN true

constexpr int NWAVES = 8;
constexpr int D = 1024, SEQ = 4096, M = 16384, NIN = 3584, FF = 2816, NGU = 2 * FF;
constexpr float NORM_EPS = 1e-6f;
constexpr size_t MiB = 1u << 20;
constexpr size_t WS_CTL = 0, CTL_ZERO_BYTES = 64 * 1024;
constexpr size_t WS_WIN = 2 * MiB, WS_WO = 9 * MiB, WS_WGU = 11 * MiB, WS_WD = 22 * MiB;
constexpr size_t WS_COS = 28 * MiB, WS_SIN = 29 * MiB;
constexpr size_t WS_A = 32 * MiB;
constexpr size_t WS_B = 64 * MiB;
constexpr size_t WS_P = 96 * MiB;
constexpr size_t WS_END = 208 * MiB;
constexpr int LDS_BYTES = 131072 + 512;

#define LAS __attribute__((address_space(3)))
typedef unsigned short bf16;
typedef unsigned v4u __attribute__((ext_vector_type(4)));
typedef unsigned v2u __attribute__((ext_vector_type(2)));
typedef float f32x4 __attribute__((ext_vector_type(4)));
typedef short bf16x8 __attribute__((ext_vector_type(8)));
#define LDS_WAIT() asm volatile("s_waitcnt lgkmcnt(0)" ::: "memory")
__device__ __forceinline__ unsigned pk2(float lo, float hi) { return pg8::cvt_pk_bf16(lo, hi); }
__device__ __forceinline__ float bflo(unsigned u) { return __uint_as_float(u << 16); }
__device__ __forceinline__ float bfhi(unsigned u) { return __uint_as_float(u & 0xffff0000u); }
__device__ __forceinline__ float wave_sum(float v) {
#pragma unroll
    for (int o = 1; o < 64; o <<= 1) v += __shfl_xor(v, o);
    return v;
}
__device__ __forceinline__ float log2_gamma(int h) { return h == 0 ? -0.04580368961312479f : h == 1 ? -0.02272007650008353f : h == 2 ? -0.011315313227834146f : -0.005646563141142063f; }

struct Frame {
    LAS unsigned char* lds;
    int tid, lane, wave, G, gw, NGW;
};

__device__ __forceinline__ void p0_tr(const float* W, int K, int N, bf16* WT, int k0, int n0, int dst0, const float* ks, LAS float* scr, int lane) {
#pragma unroll 8
    for (int i = 0; i < 32; ++i) { const int kk = 2 * i + (lane >> 5); float v = W[(size_t)(k0 + kk) * N + n0 + (lane & 31)]; if (ks) v *= ks[k0 + kk]; scr[kk * 33 + (lane & 31)] = v; }
    LDS_WAIT(); asm volatile("" ::: "memory");
    const int c = lane & 7;
#pragma unroll
    for (int j = 0; j < 4; ++j) { const int n = (lane >> 3) + 8 * j; const LAS float* s = scr + (8 * c) * 33 + n;
        v4u o; o.x = pk2(s[0 * 33], s[1 * 33]); o.y = pk2(s[2 * 33], s[3 * 33]); o.z = pk2(s[4 * 33], s[5 * 33]); o.w = pk2(s[6 * 33], s[7 * 33]);
        *(v4u*)(WT + (size_t)(dst0 + n) * K + k0 + 8 * c) = o; }
    LDS_WAIT(); asm volatile("" ::: "memory");
}
__device__ __forceinline__ void p0_prologue(const Frame& F, const float* x, const float* g1, const float* w_in, const float* w_o, const float* g2, const float* w_gate, const float* w_up, const float* w_down,
                                            bf16* Win_t, bf16* Wo_t, bf16* Wgu_t, bf16* Wd_t, float* costab, float* sintab, bf16* XN) {
    LAS float* scr = (LAS float*)(F.lds + F.wave * 16384);
    constexpr int I_IN = 16 * 112, I_O = 16 * 32, I_G = 16 * 88, I_D = 44 * 32, NITEMS = I_IN + I_O + 2 * I_G + I_D;
    for (int it = F.gw; it < NITEMS; it += F.NGW) {
        int r = it;
        if (r < I_IN) { const int kb = r / 112, nb = r % 112, n0 = 32 * nb; int dst = n0;
            if (n0 < 1024) { const int s = n0 & 255; dst = (n0 & ~255) + ((s >> 6) & 1) * 128 + (s >> 7) * 64 + (s & 63); }
            p0_tr(w_in, 1024, NIN, Win_t, 64 * kb, n0, dst, nullptr, scr, F.lane); continue; } r -= I_IN;
        if (r < I_O) { const int kb = r / 32, nb = r % 32; p0_tr(w_o, 1024, 1024, Wo_t, 64 * kb, 32 * nb, 32 * nb, nullptr, scr, F.lane); continue; } r -= I_O;
        if (r < I_G) { const int kb = r / 88, nb = r % 88, n0 = 32 * nb; p0_tr(w_gate, 1024, FF, Wgu_t, 64 * kb, n0, 256 * (n0 >> 7) + (n0 & 127), g2, scr, F.lane); continue; } r -= I_G;
        if (r < I_G) { const int kb = r / 88, nb = r % 88, n0 = 32 * nb; p0_tr(w_up, 1024, FF, Wgu_t, 64 * kb, n0, 256 * (n0 >> 7) + 128 + (n0 & 127), g2, scr, F.lane); continue; } r -= I_G;
        { const int kb = r / 32, nb = r % 32; p0_tr(w_down, FF, 1024, Wd_t, 64 * kb, 32 * nb, 32 * nb, nullptr, scr, F.lane); }
    }
    for (int idx = F.gw * 64 + F.lane; idx < SEQ * 64; idx += F.NGW * 64) {
        const int pos = idx >> 6, i = idx & 63;
        double f = 1.0;
        if (i & 1) f *= 0.8659643233600653; if (i & 2) f *= 0.7498942093324558; if (i & 4) f *= 0.5623413251903491;
        if (i & 8) f *= 0.31622776601683794; if (i & 16) f *= 0.09999999999999999; if (i & 32) f *= 0.009999999999999998;
        const double ang = (double)pos * f;
        const double q = __builtin_rint(ang * 0.6366197723675814);
        double s = __builtin_fma(-q, 1.5707963267948966, ang); s = __builtin_fma(-q, 6.123233995736766e-17, s);
        const double s2 = s * s;
        double sn = 1.0 / 6227020800.0; sn = sn * s2 - 1.0 / 39916800.0; sn = sn * s2 + 1.0 / 362880.0; sn = sn * s2 - 1.0 / 5040.0; sn = sn * s2 + 1.0 / 120.0; sn = sn * s2 - 1.0 / 6.0; sn = sn * s2 + 1.0; sn *= s;
        double cn = -1.0 / 87178291200.0; cn = cn * s2 + 1.0 / 479001600.0; cn = cn * s2 - 1.0 / 3628800.0; cn = cn * s2 + 1.0 / 40320.0; cn = cn * s2 - 1.0 / 720.0; cn = cn * s2 + 1.0 / 24.0; cn = cn * s2 - 0.5; cn = cn * s2 + 1.0;
        const int qi = (int)q & 3;
        const double sv = (qi == 0) ? sn : (qi == 1) ? cn : (qi == 2) ? -sn : -cn;
        const double cv = (qi == 0) ? cn : (qi == 1) ? -sn : (qi == 2) ? -cn : sn;
        costab[idx] = (float)cv; sintab[idx] = (float)sv;
    }
    for (int m = F.gw; m < M; m += F.NGW) {
        const f32x4* xr = (const f32x4*)(x + (size_t)m * D) + F.lane; const f32x4* gr = (const f32x4*)g1 + F.lane;
        f32x4 v[4]; float s = 0.f;
#pragma unroll
        for (int j = 0; j < 4; ++j) { v[j] = xr[64 * j]; s += (v[j].x * v[j].x + v[j].y * v[j].y) + (v[j].z * v[j].z + v[j].w * v[j].w); }
        const float rstd = __builtin_amdgcn_rsqf(wave_sum(s) * (1.f / D) + NORM_EPS);
        v2u* o8 = (v2u*)(XN + (size_t)m * D) + F.lane;
#pragma unroll
        for (int j = 0; j < 4; ++j) { const f32x4 g = gr[64 * j]; v2u o; o.x = pk2(v[j].x * rstd * g.x, v[j].y * rstd * g.y); o.y = pk2(v[j].z * rstd * g.z, v[j].w * rstd * g.w); o8[64 * j] = o; }
    }
}

__device__ __forceinline__ void p2a_item(const Frame& F, const bf16* PROJ, bf16* ST, int item) {
    const int tid = F.tid, lane = F.lane, w = F.wave, fr = lane & 15, fq = lane >> 4;
    const int h = item & 3, n = (item >> 2) & 63, b = item >> 8, bh = b * 4 + h;
    const size_t tok0 = (size_t)b * SEQ + n * 64;
    const int kc0 = 512 + 256 * (h >> 1) + 64 * (h & 1), vc0 = 1024 + h * 128;
    LAS bf16* KT = (LAS bf16*)F.lds;
    LAS bf16* VT = KT + 128 * 72;
    const float l2g = log2_gamma(h);
#pragma unroll
    for (int i = 0; i < 2; ++i) { const int c = tid + 512 * i, j = c >> 4, cc = c & 15;
        const bf16* rp = PROJ + (tok0 + j) * NIN;
        const v4u kv = *(const v4u*)(rp + kc0 + (cc & 7) * 8 + (cc >> 3) * 128);
        const v4u vv = *(const v4u*)(rp + vc0 + cc * 8);
        const float zeta = __builtin_amdgcn_exp2f(l2g * (float)(63 - j));
        LAS bf16* kd = KT + (cc * 8) * 72 + j; LAS bf16* vd = VT + (cc * 8) * 72 + j;
#pragma unroll
        for (int q = 0; q < 4; ++q) { const unsigned ku = kv[q], vu = vv[q];
            kd[(2 * q) * 72] = (bf16)(ku & 0xffffu); kd[(2 * q + 1) * 72] = (bf16)(ku >> 16);
            const unsigned p = pk2(bflo(vu) * zeta, bfhi(vu) * zeta);
            vd[(2 * q) * 72] = (bf16)(p & 0xffffu); vd[(2 * q + 1) * 72] = (bf16)(p >> 16); } }
    __syncthreads();
    bf16x8 a[2];
#pragma unroll
    for (int kk = 0; kk < 2; ++kk) a[kk] = *(const LAS bf16x8*)(KT + (w * 16 + fr) * 72 + kk * 32 + fq * 8);
    bf16* dst = ST + ((size_t)(bh * 64 + n) * 128) * 128 + w * 16 + 4 * fq;
#pragma unroll
    for (int et = 0; et < 8; ++et) {
        f32x4 acc = (f32x4){0.f, 0.f, 0.f, 0.f};
#pragma unroll
        for (int kk = 0; kk < 2; ++kk) { const bf16x8 bb = *(const LAS bf16x8*)(VT + (et * 16 + fr) * 72 + kk * 32 + fq * 8); acc = __builtin_amdgcn_mfma_f32_16x16x32_bf16(a[kk], bb, acc, 0, 0, 0); }
        v2u o; o.x = pk2(acc[0], acc[1]); o.y = pk2(acc[2], acc[3]);
        *(v2u*)(dst + (size_t)(et * 16 + fr) * 128) = o;
    }
    __syncthreads();
}
__device__ __forceinline__ void p2b_scan(const Frame& F, bf16* ST) {
    for (int p = blockIdx.x * 512 + F.tid; p < 16 * 8192; p += F.G * 512) {
        const int bh = p >> 13, off = (p & 8191) * 2;
        const float cd = __builtin_amdgcn_exp2f(64.f * log2_gamma(bh & 3));
        unsigned* base = (unsigned*)(ST + (size_t)bh * 64 * 16384 + off);
        float s0 = 0.f, s1 = 0.f;
#pragma unroll 8
        for (int n = 0; n < 64; ++n) { const unsigned v = base[(size_t)n * 8192]; base[(size_t)n * 8192] = pk2(s0, s1); s0 = cd * s0 + bflo(v); s1 = cd * s1 + bfhi(v); }
    }
}
constexpr int QS_OFF = 0, KS_OFF = 17408, VT_OFF = 34816, ST_OFF = 53248, SB_OFF = 88064, RED_OFF = 97280;
__device__ __forceinline__ void p2c_item(const Frame& F, const bf16* PROJ, const bf16* ST, const float* gnw, bf16* MIX, int item) {
    const int tid = F.tid, lane = F.lane, w = F.wave, fr = lane & 15, fq = lane >> 4;
    const int h = item & 3, n = (item >> 2) & 63, b = item >> 8, bh = b * 4 + h;
    const size_t tok0 = (size_t)b * SEQ + n * 64;
    const int qc0 = 256 * (h >> 1) + 64 * (h & 1), vc0 = 1024 + h * 128;
    LAS bf16* Qs = (LAS bf16*)(F.lds + QS_OFF);
    LAS bf16* Ks = (LAS bf16*)(F.lds + KS_OFF);
    LAS bf16* VT = (LAS bf16*)(F.lds + VT_OFF);
    LAS bf16* Ss = (LAS bf16*)(F.lds + ST_OFF);
    LAS bf16* Sb = (LAS bf16*)(F.lds + SB_OFF);
    LAS float* red = (LAS float*)(F.lds + RED_OFF);
    const float l2g = log2_gamma(h);
#pragma unroll
    for (int i = 0; i < 2; ++i) { const int c = tid + 512 * i, j = c >> 4, cc = c & 15;
        const bf16* rp = PROJ + (tok0 + j) * NIN; const int qcol = qc0 + (cc & 7) * 8 + (cc >> 3) * 128;
        const v4u qv = *(const v4u*)(rp + qcol), kv = *(const v4u*)(rp + 512 + qcol), vv = *(const v4u*)(rp + vc0 + cc * 8);
        *(LAS v4u*)(Qs + j * 136 + cc * 8) = qv; *(LAS v4u*)(Ks + j * 136 + cc * 8) = kv;
        LAS bf16* vd = VT + (cc * 8) * 72 + j;
#pragma unroll
        for (int q = 0; q < 4; ++q) { const unsigned vu = vv[q]; vd[(2 * q) * 72] = (bf16)(vu & 0xffffu); vd[(2 * q + 1) * 72] = (bf16)(vu >> 16); } }
    { const bf16* sp = ST + ((size_t)(bh * 64 + n) * 128) * 128;
#pragma unroll
      for (int i = 0; i < 4; ++i) { const int c = tid + 512 * i, e = c >> 4, cc = c & 15; *(LAS v4u*)(Ss + e * 136 + cc * 8) = *(const v4u*)(sp + e * 128 + cc * 8); } }
    __syncthreads();
    const int rb = w >> 1, half = w & 1, irow = rb * 16 + fr;
    bf16x8 qf[4];
#pragma unroll
    for (int kk = 0; kk < 4; ++kk) qf[kk] = *(const LAS bf16x8*)(Qs + irow * 136 + kk * 32 + fq * 8);
#pragma unroll
    for (int jj = 0; jj < 2; ++jj) { const int jt = half * 2 + jj;
        f32x4 acc = (f32x4){0.f, 0.f, 0.f, 0.f};
#pragma unroll
        for (int kk = 0; kk < 4; ++kk) { const bf16x8 kf = *(const LAS bf16x8*)(Ks + (jt * 16 + fr) * 136 + kk * 32 + fq * 8); acc = __builtin_amdgcn_mfma_f32_16x16x32_bf16(kf, qf[kk], acc, 0, 0, 0); }
        float o[4];
#pragma unroll
        for (int t = 0; t < 4; ++t) { const int dj = irow - (jt * 16 + 4 * fq + t); o[t] = acc[t] * __builtin_amdgcn_exp2f(l2g * (float)(dj < 0 ? -dj : dj)); }
        v2u pkd; pkd.x = pk2(o[0], o[1]); pkd.y = pk2(o[2], o[3]);
        *(LAS v2u*)(Sb + irow * 72 + jt * 16 + 4 * fq) = pkd; }
    __syncthreads();
    bf16x8 sf[2];
#pragma unroll
    for (int kk = 0; kk < 2; ++kk) sf[kk] = *(const LAS bf16x8*)(Sb + irow * 72 + kk * 32 + fq * 8);
    const float xi = __builtin_amdgcn_exp2f(l2g * (float)(irow + 1));
    f32x4 o[4]; float ss = 0.f;
#pragma unroll
    for (int ct = 0; ct < 4; ++ct) { const int e0 = half * 64 + ct * 16;
        f32x4 ai = (f32x4){0.f, 0.f, 0.f, 0.f}, ac = (f32x4){0.f, 0.f, 0.f, 0.f};
#pragma unroll
        for (int kk = 0; kk < 2; ++kk) { const bf16x8 vf = *(const LAS bf16x8*)(VT + (e0 + fr) * 72 + kk * 32 + fq * 8); ai = __builtin_amdgcn_mfma_f32_16x16x32_bf16(vf, sf[kk], ai, 0, 0, 0); }
#pragma unroll
        for (int kk = 0; kk < 4; ++kk) { const bf16x8 tf = *(const LAS bf16x8*)(Ss + (e0 + fr) * 136 + kk * 32 + fq * 8); ac = __builtin_amdgcn_mfma_f32_16x16x32_bf16(tf, qf[kk], ac, 0, 0, 0); }
        o[ct] = ai + ac * xi;
        ss += (o[ct][0] * o[ct][0] + o[ct][1] * o[ct][1]) + (o[ct][2] * o[ct][2] + o[ct][3] * o[ct][3]); }
    ss += __shfl_xor(ss, 16); ss += __shfl_xor(ss, 32);
    if (fq == 0) red[w * 16 + fr] = ss;
    __syncthreads();
    const float tot = red[(rb * 2) * 16 + fr] + red[(rb * 2 + 1) * 16 + fr];
    const float rstd = __builtin_amdgcn_rsqf(tot * (1.0f / 128.0f) + NORM_EPS);
    const size_t trow = tok0 + irow;
#pragma unroll
    for (int ct = 0; ct < 4; ++ct) { const int e = half * 64 + ct * 16 + 4 * fq;
        const f32x4 gw = *(const f32x4*)(gnw + h * 128 + e);
        const v2u gu = *(const v2u*)(PROJ + trow * NIN + 1536 + h * 128 + e);
        float g[4] = {bflo(gu.x), bfhi(gu.x), bflo(gu.y), bfhi(gu.y)}; float r[4];
#pragma unroll
        for (int t = 0; t < 4; ++t) r[t] = o[ct][t] * rstd * gw[t] * (g[t] * __builtin_amdgcn_rcpf(1.0f + __builtin_amdgcn_exp2f(g[t] * -1.4426950408889634f)));
        v2u pkd; pkd.x = pk2(r[0], r[1]); pkd.y = pk2(r[2], r[3]);
        *(v2u*)(MIX + trow * 1024 + h * 128 + e) = pkd; }
}
__device__ __forceinline__ void p2c_conv(const Frame& F, const bf16* PROJ, const float* wconv, bf16* MIX) {
    for (int id = blockIdx.x * 512 + F.tid; id < (M / 8) * 64; id += F.G * 512) {
        const int cv = id & 63, tg = id >> 6, c0 = cv * 8, t0 = tg * 8;
        float w0[8], w1[8], w2[8];
#pragma unroll
        for (int q = 0; q < 2; ++q) { const f32x4 a = *(const f32x4*)(wconv + c0 + 4 * q), bq = *(const f32x4*)(wconv + 512 + c0 + 4 * q), cq = *(const f32x4*)(wconv + 1024 + c0 + 4 * q);
#pragma unroll
            for (int t = 0; t < 4; ++t) { w0[4 * q + t] = a[t]; w1[4 * q + t] = bq[t]; w2[4 * q + t] = cq[t]; } }
        float u2[8], u1[8];
        const bool first = (t0 & (SEQ - 1)) == 0;
#pragma unroll
        for (int r = 0; r < 2; ++r) { float* up = r == 0 ? u2 : u1;
            if (first) {
#pragma unroll
                for (int q = 0; q < 8; ++q) up[q] = 0.f;
            } else { const bf16* rp = PROJ + (size_t)(t0 - 2 + r) * NIN; const v4u cc = *(const v4u*)(rp + 2560 + c0), ch = *(const v4u*)(rp + 3072 + c0);
#pragma unroll
                for (int q = 0; q < 4; ++q) { up[2 * q] = bflo(cc[q]) * bflo(ch[q]); up[2 * q + 1] = bfhi(cc[q]) * bfhi(ch[q]); } } }
#pragma unroll
        for (int t = 0; t < 8; ++t) { const bf16* rp = PROJ + (size_t)(t0 + t) * NIN;
            const v4u cb = *(const v4u*)(rp + 2048 + c0), cc = *(const v4u*)(rp + 2560 + c0), ch = *(const v4u*)(rp + 3072 + c0);
            float u0[8], o[8];
#pragma unroll
            for (int q = 0; q < 4; ++q) { u0[2 * q] = bflo(cc[q]) * bflo(ch[q]); u0[2 * q + 1] = bfhi(cc[q]) * bfhi(ch[q]); }
#pragma unroll
            for (int q = 0; q < 4; ++q) { o[2 * q] = bflo(cb[q]) * (w0[2 * q] * u2[2 * q] + w1[2 * q] * u1[2 * q] + w2[2 * q] * u0[2 * q]);
                o[2 * q + 1] = bfhi(cb[q]) * (w0[2 * q + 1] * u2[2 * q + 1] + w1[2 * q + 1] * u1[2 * q + 1] + w2[2 * q + 1] * u0[2 * q + 1]); }
            v4u pkd; pkd.x = pk2(o[0], o[1]); pkd.y = pk2(o[2], o[3]); pkd.z = pk2(o[4], o[5]); pkd.w = pk2(o[6], o[7]);
            *(v4u*)(MIX + (size_t)(t0 + t) * 1024 + 512 + c0) = pkd;
#pragma unroll
            for (int q = 0; q < 8; ++q) { u2[q] = u1[q]; u1[q] = u0[q]; } }
    }
}

struct Args { const float* in[11]; float* out; unsigned char* ws; };
__global__ void __launch_bounds__(NWAVES * 64, 2) mk_fwd(Args args) {
    extern __shared__ __attribute__((aligned(16))) unsigned char lds[];
    cg::grid_group grid = cg::this_grid();
    Frame F;
    F.lds = (LAS unsigned char*)lds;
    F.tid = threadIdx.x; F.lane = F.tid & 63; F.wave = __builtin_amdgcn_readfirstlane(F.tid >> 6);
    F.G = gridDim.x; F.gw = blockIdx.x * NWAVES + F.wave; F.NGW = F.G * NWAVES;
    unsigned char* ws = args.ws;
    const float* x = args.in[0]; const float* norm1_w = args.in[1]; const float* w_in = args.in[2]; const float* w_conv = args.in[3]; const float* gn_w = args.in[4];
    const float* w_o = args.in[5]; const float* norm2_w = args.in[6]; const float* w_gate = args.in[7]; const float* w_up = args.in[8]; const float* w_down = args.in[9]; const float* fin_w = args.in[10];
    float* out = args.out;
    float* rowss = (float*)(ws + WS_CTL);
    bf16* Win_t = (bf16*)(ws + WS_WIN); bf16* Wo_t = (bf16*)(ws + WS_WO); bf16* Wgu_t = (bf16*)(ws + WS_WGU); bf16* Wd_t = (bf16*)(ws + WS_WD);
    float* costab = (float*)(ws + WS_COS); float* sintab = (float*)(ws + WS_SIN);
    bf16* XN = (bf16*)(ws + WS_A); bf16* MIX = (bf16*)(ws + WS_A);
    bf16* ST = (bf16*)(ws + WS_B); bf16* X1B = (bf16*)(ws + WS_B);
    bf16* PROJ = (bf16*)(ws + WS_P); bf16* HB = (bf16*)(ws + WS_P);

#define GSYNC() do { asm volatile("s_waitcnt vmcnt(0)" ::: "memory"); grid.sync(); \
        if (threadIdx.x == 0) { __builtin_amdgcn_fence(__ATOMIC_ACQUIRE, "agent"); asm volatile("s_waitcnt vmcnt(0)" ::: "memory"); } __syncthreads(); } while (0)
    for (int i = blockIdx.x * 512 + F.tid; i < M; i += F.G * 512) rowss[i] = 0.f;
    p0_prologue(F, x, norm1_w, w_in, w_o, norm2_w, w_gate, w_up, w_down, Win_t, Wo_t, Wgu_t, Wd_t, costab, sintab, XN);
    GSYNC();
    { pg8::Gemm g{XN, Win_t, M, NIN, D}; pg8::StaticOrder S; S.init(M, NIN, F.G, (int)blockIdx.x);
      pg8::EpiProj E{PROJ, costab, sintab};
      pg8::gemm_phase<pg8::EpiProj, pg8::StaticOrder, PG8_ALIGN, PG8_SP2>(F.lds, g, S, E); }
    GSYNC();
#ifdef DBG_AFTER_P1
    for (int m = F.gw; m < M; m += F.NGW) { const bf16* pr = PROJ + (size_t)m * NIN;
        for (int c = F.lane; c < 1024; c += 64) { float v = bflo(pr[c]) + bflo(pr[c + 1024]) + bflo(pr[c + 2048]) + (c < 512 ? bflo(pr[c + 3072]) : 0.f); out[(size_t)m * D + c] = v; } }
    return;
#endif
    for (int it = blockIdx.x; it < 1024; it += F.G) p2a_item(F, PROJ, ST, it);
    GSYNC();
#ifdef DBG_AFTER_P2A
    for (int m = F.gw; m < M; m += F.NGW) { const bf16* pr = ST + (size_t)m * 1024;
        for (int c = F.lane; c < 1024; c += 64) out[(size_t)m * D + c] = bflo(pr[c]); }
    return;
#endif
    p2b_scan(F, ST);
    GSYNC();
#ifdef DBG_AFTER_P2B
    for (int m = F.gw; m < M; m += F.NGW) { const bf16* pr = ST + (size_t)m * 1024;
        for (int c = F.lane; c < 1024; c += 64) out[(size_t)m * D + c] = bflo(pr[c]); }
    return;
#endif
    for (int it = blockIdx.x; it < 1024; it += F.G) p2c_item(F, PROJ, ST, gn_w, MIX, it);
    p2c_conv(F, PROJ, w_conv, MIX);
    GSYNC();
#ifdef DBG_AFTER_P2C
    for (int m = F.gw; m < M; m += F.NGW) { const bf16* pr = MIX + (size_t)m * 1024;
        for (int c = F.lane; c < 1024; c += 64) out[(size_t)m * D + c] = bflo(pr[c]); }
    return;
#endif
    { pg8::Gemm g{MIX, Wo_t, M, D, D}; pg8::StaticOrder S; S.init(M, D, F.G, (int)blockIdx.x);
      pg8::EpiRes1 E{x, out, X1B, rowss};
      pg8::gemm_phase<pg8::EpiRes1, pg8::StaticOrder, PG8_ALIGN, PG8_SP2>(F.lds, g, S, E); }
    GSYNC();
    { pg8::Gemm g{X1B, Wgu_t, M, NGU, D}; pg8::StaticOrder S; S.init(M, NGU, F.G, (int)blockIdx.x);
      pg8::EpiGU E{HB, rowss};
      pg8::gemm_phase<pg8::EpiGU, pg8::StaticOrder, PG8_ALIGN, PG8_SP2>(F.lds, g, S, E); }
    GSYNC();
    { pg8::Gemm g{HB, Wd_t, M, D, FF}; pg8::StaticOrder S; S.init(M, D, F.G, (int)blockIdx.x);
      pg8::EpiRes2 E{out};
      pg8::gemm_phase<pg8::EpiRes2, pg8::StaticOrder, PG8_ALIGN, PG8_SP2>(F.lds, g, S, E); }
    GSYNC();
    for (int m = F.gw; m < M; m += F.NGW) {
        f32x4* xr = (f32x4*)(out + (size_t)m * D) + F.lane; const f32x4* gr = (const f32x4*)fin_w + F.lane;
        f32x4 v[4]; float s = 0.f;
#pragma unroll
        for (int j = 0; j < 4; ++j) { v[j] = xr[64 * j]; s += (v[j].x * v[j].x + v[j].y * v[j].y) + (v[j].z * v[j].z + v[j].w * v[j].w); }
        const float rstd = __builtin_amdgcn_rsqf(wave_sum(s) * (1.f / D) + NORM_EPS);
#pragma unroll
        for (int j = 0; j < 4; ++j) { const f32x4 g = gr[64 * j]; xr[64 * j] = v[j] * rstd * g; }
    }
}

extern "C" void kernel_launch(void* const* d_in, const int* in_sizes, int n_in, void* d_out, int out_size, void* d_ws, size_t ws_size, hipStream_t stream) {
    static int grid = 0;
    if (grid == 0) {
        if (n_in != 11 || out_size != M * D || ws_size < WS_END) { fprintf(stderr, "kernel_launch: unexpected shapes (n_in %d out %d ws %zu)\n", n_in, out_size, ws_size); grid = -1; return; }
        int dev = 0, cus = 0, per_cu = 0;
        hipGetDevice(&dev);
        hipDeviceGetAttribute(&cus, hipDeviceAttributeMultiprocessorCount, dev);
        if (hipFuncSetAttribute((const void*)mk_fwd, hipFuncAttributeMaxDynamicSharedMemorySize, LDS_BYTES) != hipSuccess) { fprintf(stderr, "kernel_launch: hipFuncSetAttribute failed\n"); grid = -1; return; }
        if (hipOccupancyMaxActiveBlocksPerMultiprocessor(&per_cu, (const void*)mk_fwd, NWAVES * 64, LDS_BYTES) != hipSuccess || per_cu < 1) { fprintf(stderr, "kernel_launch: occupancy query failed (%d)\n", per_cu); (void)hipGetLastError(); per_cu = 1; }
        if (per_cu > 1) per_cu = 1;
        grid = cus * per_cu;
    }
    if (grid < 0) return;
    Args a{};
    for (int i = 0; i < 11; ++i) a.in[i] = (const float*)d_in[i];
    a.out = (float*)d_out; a.ws = (unsigned char*)d_ws;
    void* kargs[] = {&a};
    hipError_t e = hipLaunchCooperativeKernel((const void*)mk_fwd, dim3(grid), dim3(NWAVES * 64), kargs, LDS_BYTES, stream);
    if (e != hipSuccess) fprintf(stderr, "kernel_launch: cooperative launch failed: %s (grid %d)\n", hipGetErrorString(e), grid);
}
```

```cpp
#include <hip/hip_runtime.h>
#include <hip/hip_cooperative_groups.h>
#include <cstdio>
#include <cstdint>
namespace cg = cooperative_groups;
namespace pg8 {
#define PG8_LAS __attribute__((address_space(3)))
typedef unsigned short bf16_t;
typedef short bf16x8 __attribute__((ext_vector_type(8)));
typedef float f32x4 __attribute__((ext_vector_type(4)));
typedef unsigned u32x4 __attribute__((ext_vector_type(4)));
constexpr int BM = 256, BK = 64, HALF = 128, HTB = HALF * BK * 2  , STAGE_BYTES = 8 * HTB, NXCD = 8, WGM = 8;

__host__ __device__ __forceinline__ int lds_byte(int r, int c) { const int st = (r >> 4) * 2 + (c >> 5), rr = r & 15, cc = c & 31, ob = rr * 64 + cc * 2; return st * 1024 + (ob ^ (((ob >> 9) & 1) << 5)); }
__host__ __device__ __forceinline__ void stage_rc(int b, int& R, int& C) { const int st = b / 1024, sb = b % 1024, swz = sb ^ (((sb >> 9) & 1) << 5); R = (st >> 1) * 16 + swz / 64; C = (st & 1) * 32 + (swz % 64) / 2; }
__host__ __device__ __forceinline__ int perm32(int rho) { const int n = rho >> 4, i = rho & 15; return 8 * (i >> 2) + 4 * n + (i & 3); }

struct Unit { int pm, pn; };
struct Gemm { const bf16_t* A; const bf16_t* Bt; int M, N, K; };

struct StaticOrder {
    int nM, nN, nwg, G, c;
    __host__ __device__ void init(int M, int N, int G_, int c_) { nM = M / BM; nN = N / BM; nwg = nM * nN; G = G_; c = c_; }
    __host__ __device__ bool next(int i, Unit& u) const {
        const long L = (long)i * G + c; if (L >= nwg) return false;
        int wgid = (int)L; { const int q = nwg / NXCD, r = nwg % NXCD, xcd = wgid % NXCD, off = wgid / NXCD; wgid = (xcd < r ? xcd * (q + 1) : r * (q + 1) + (xcd - r) * q) + off; }
        const int nig = WGM * nN, gid = wgid / nig, fm = gid * WGM, gsz = (nM - fm) < WGM ? (nM - fm) : WGM;
        u.pm = fm + ((wgid % nig) % gsz); u.pn = (wgid % nig) / gsz; return true;
    }
    __device__ __forceinline__ void a_ready(const Unit&) const {}
    __device__ __forceinline__ void done(const Unit&) const {}
};


typedef float f32x2_t __attribute__((ext_vector_type(2))); typedef __bf16 bf16x2_t __attribute__((ext_vector_type(2)));
__device__ __forceinline__ unsigned cvt_pk_bf16(float lo, float hi) { f32x2_t v = {lo, hi}; bf16x2_t b = __builtin_convertvector(v, bf16x2_t); return __builtin_bit_cast(unsigned, b); }

struct EpiProj {
    static constexpr bool PERM = true, AFTER_DRAIN = false;
    bf16_t* O; const float* costab; const float* sintab;
    __device__ __forceinline__ void operator()(const f32x4 (&acc)[2][2][4][2], const Unit& u, int wr, int wc, int fr, int fq) const {
        const int row0 = u.pm * BM + wr * 64 + fr, col0 = u.pn * BM + wc * 32 + 8 * fq;
        if (u.pn < 4) {
            const float sc = (u.pn < 2) ? 0.08838834764831845f : 1.0f;
            const int dd0 = (wc & 1) * 32 + 8 * fq;
#pragma unroll
            for (int ai = 0; ai < 2; ++ai)
#pragma unroll
                for (int m = 0; m < 4; ++m) {
                    const int row = row0 + ai * HALF + m * 16, pos = row & 4095;
                    const f32x4 c0 = *(const f32x4*)(costab + pos * 64 + dd0), c1 = *(const f32x4*)(costab + pos * 64 + dd0 + 4);
                    const f32x4 s0 = *(const f32x4*)(sintab + pos * 64 + dd0), s1 = *(const f32x4*)(sintab + pos * 64 + dd0 + 4);
                    const f32x4 a0 = acc[ai][0][m][0], a1 = acc[ai][0][m][1], b0 = acc[ai][1][m][0], b1 = acc[ai][1][m][1];
                    const f32x4 o10 = (a0 * c0 - b0 * s0) * sc, o11 = (a1 * c1 - b1 * s1) * sc, o20 = (a0 * s0 + b0 * c0) * sc, o21 = (a1 * s1 + b1 * c1) * sc;
                    bf16_t* rowp = O + (size_t)row * 3584 + col0;
                    u32x4 w; w.x = cvt_pk_bf16(o10[0], o10[1]); w.y = cvt_pk_bf16(o10[2], o10[3]); w.z = cvt_pk_bf16(o11[0], o11[1]); w.w = cvt_pk_bf16(o11[2], o11[3]);
                    *(u32x4*)rowp = w;
                    w.x = cvt_pk_bf16(o20[0], o20[1]); w.y = cvt_pk_bf16(o20[2], o20[3]); w.z = cvt_pk_bf16(o21[0], o21[1]); w.w = cvt_pk_bf16(o21[2], o21[3]);
                    *(u32x4*)(rowp + HALF) = w;
                }
        } else {
#pragma unroll
            for (int ai = 0; ai < 2; ++ai)
#pragma unroll
                for (int m = 0; m < 4; ++m) { bf16_t* rowp = O + (size_t)(row0 + ai * HALF + m * 16) * 3584 + col0;
#pragma unroll
                    for (int bj = 0; bj < 2; ++bj) { const f32x4 v0 = acc[ai][bj][m][0], v1 = acc[ai][bj][m][1];
                        u32x4 w; w.x = cvt_pk_bf16(v0[0], v0[1]); w.y = cvt_pk_bf16(v0[2], v0[3]); w.z = cvt_pk_bf16(v1[0], v1[1]); w.w = cvt_pk_bf16(v1[2], v1[3]);
                        *(u32x4*)(rowp + bj * HALF) = w; } }
        }
    }
};
struct EpiRes1 {
    static constexpr bool PERM = true, AFTER_DRAIN = false;
    const float* x; float* out; bf16_t* xb; float* rowss;
    __device__ __forceinline__ void operator()(const f32x4 (&acc)[2][2][4][2], const Unit& u, int wr, int wc, int fr, int fq) const {
        const int row0 = u.pm * BM + wr * 64 + fr, col0 = u.pn * BM + wc * 32 + 8 * fq;
#pragma unroll
        for (int ai = 0; ai < 2; ++ai)
#pragma unroll
            for (int m = 0; m < 4; ++m) { const int row = row0 + ai * HALF + m * 16; const size_t off = (size_t)row * 1024 + col0; float ss = 0.f;
#pragma unroll
                for (int bj = 0; bj < 2; ++bj) {
                    const f32x4 v0 = acc[ai][bj][m][0] + *(const f32x4*)(x + off + bj * HALF), v1 = acc[ai][bj][m][1] + *(const f32x4*)(x + off + bj * HALF + 4);
                    *(f32x4*)(out + off + bj * HALF) = v0; *(f32x4*)(out + off + bj * HALF + 4) = v1;
                    u32x4 w; w.x = cvt_pk_bf16(v0[0], v0[1]); w.y = cvt_pk_bf16(v0[2], v0[3]); w.z = cvt_pk_bf16(v1[0], v1[1]); w.w = cvt_pk_bf16(v1[2], v1[3]);
                    *(u32x4*)(xb + off + bj * HALF) = w;
                    ss += (v0[0] * v0[0] + v0[1] * v0[1]) + (v0[2] * v0[2] + v0[3] * v0[3]) + (v1[0] * v1[0] + v1[1] * v1[1]) + (v1[2] * v1[2] + v1[3] * v1[3]); }
                ss += __shfl_xor(ss, 16); ss += __shfl_xor(ss, 32);
                if (fq == 0) (void)__hip_atomic_fetch_add(rowss + row, ss, __ATOMIC_RELAXED, __HIP_MEMORY_SCOPE_AGENT); }
    }
};
struct EpiGU {
    static constexpr bool PERM = true, AFTER_DRAIN = false;
    bf16_t* Hh; const float* rowss;
    __device__ __forceinline__ void operator()(const f32x4 (&acc)[2][2][4][2], const Unit& u, int wr, int wc, int fr, int fq) const {
        const int row0 = u.pm * BM + wr * 64 + fr, col0 = u.pn * HALF + wc * 32 + 8 * fq;
#pragma unroll
        for (int ai = 0; ai < 2; ++ai)
#pragma unroll
            for (int m = 0; m < 4; ++m) { const int row = row0 + ai * HALF + m * 16;
                const float rstd = __builtin_amdgcn_rsqf(rowss[row] * (1.0f / 1024.0f) + 1e-6f);
                unsigned w[4];
#pragma unroll
                for (int n = 0; n < 2; ++n) { const f32x4 g = acc[ai][0][m][n] * rstd, up = acc[ai][1][m][n] * rstd; float o[4];
#pragma unroll
                    for (int j = 0; j < 4; ++j) o[j] = g[j] * __builtin_amdgcn_rcpf(1.0f + __builtin_amdgcn_exp2f(g[j] * -1.4426950408889634f)) * up[j];
                    w[2 * n] = cvt_pk_bf16(o[0], o[1]); w[2 * n + 1] = cvt_pk_bf16(o[2], o[3]); }
                *(u32x4*)(Hh + (size_t)row * 2816 + col0) = (u32x4){w[0], w[1], w[2], w[3]}; }
    }
};
struct EpiRes2 {
    static constexpr bool PERM = true, AFTER_DRAIN = false;
    float* out;
    __device__ __forceinline__ void operator()(const f32x4 (&acc)[2][2][4][2], const Unit& u, int wr, int wc, int fr, int fq) const {
        const int row0 = u.pm * BM + wr * 64 + fr, col0 = u.pn * BM + wc * 32 + 8 * fq;
#pragma unroll
        for (int ai = 0; ai < 2; ++ai)
#pragma unroll
            for (int m = 0; m < 4; ++m) { const size_t off = (size_t)(row0 + ai * HALF + m * 16) * 1024 + col0;
#pragma unroll
                for (int bj = 0; bj < 2; ++bj) {
                    const f32x4 v0 = acc[ai][bj][m][0] + *(const f32x4*)(out + off + bj * HALF), v1 = acc[ai][bj][m][1] + *(const f32x4*)(out + off + bj * HALF + 4);
                    *(f32x4*)(out + off + bj * HALF) = v0; *(f32x4*)(out + off + bj * HALF + 4) = v1; } }
    }
};

template <class Epi, class Sched, bool ALIGN_EPI = false, bool SP2 = false>
__device__ __forceinline__ void gemm_phase(PG8_LAS unsigned char* lds, const Gemm g, const Sched& S, const Epi& E) {
    const int tid = threadIdx.x, wid = __builtin_amdgcn_readfirstlane(tid >> 6), lane = tid & 63, wr = wid >> 2, wc = wid & 3, fr = lane & 15, fq = lane >> 4;
    const int K = g.K, nt = K / BK;
    unsigned voffA[2], voffB[2];
#pragma unroll
    for (int i = 0; i < 2; ++i) { int R, C; stage_rc(tid * 16 + i * 8192, R, C); const int Rb = Epi::PERM ? ((R & ~31) + perm32(R & 31)) : R;
        voffA[i] = (unsigned)(R * K + C) * 2u; voffB[i] = (unsigned)(Rb * K + C) * 2u; }
    const size_t kstep = (size_t)(BK * 2);
    const size_t hstep = (size_t)HALF * K * 2;
    const size_t tstep = 2 * hstep;
    const unsigned ldsw = (unsigned)wid * 1024u;
    const int aoff = lds_byte(wr * 64 + fr, fq * 8), boff = lds_byte(wc * 32 + fr, fq * 8);
#define PG8_SA(b, h) (((b) * 2 + (h)) * HTB)
#define PG8_SB(b, h) ((4 + (b) * 2 + (h)) * HTB)
#define PG8_STAGE(bufoff, gbase, voff) do { _Pragma("unroll") for (int _i = 0; _i < 2; ++_i) \
        __builtin_amdgcn_global_load_lds((const unsigned*)((const char*)(gbase) + (voff)[_i]), (PG8_LAS unsigned*)(lds + (bufoff) + ldsw + _i * 8192), 16, 0, 0); } while (0)
#define PG8_LDA(dst, b, h) do { _Pragma("unroll") for (int m = 0; m < 4; ++m) _Pragma("unroll") for (int k = 0; k < 2; ++k) dst[m][k] = *(const PG8_LAS bf16x8*)(lds + PG8_SA(b, h) + aoff + m * 2048 + k * 1024); } while (0)
#define PG8_LDB(dst, b, h) do { _Pragma("unroll") for (int n = 0; n < 2; ++n) _Pragma("unroll") for (int k = 0; k < 2; ++k) dst[n][k] = *(const PG8_LAS bf16x8*)(lds + PG8_SB(b, h) + boff + n * 2048 + k * 1024); } while (0)
#define PG8_MMA(ai, bj, At, Bt) do { __builtin_amdgcn_s_setprio(1); _Pragma("unroll") for (int m = 0; m < 4; ++m) _Pragma("unroll") for (int n = 0; n < 2; ++n) _Pragma("unroll") for (int k = 0; k < 2; ++k) \
        acc[ai][bj][m][n] = __builtin_amdgcn_mfma_f32_16x16x32_bf16(Bt[n][k], At[m][k], acc[ai][bj][m][n], 0, 0, 0); __builtin_amdgcn_s_setprio(0); } while (0)
#define PG8_WAIT_V(n) asm volatile("s_waitcnt vmcnt(" #n ")" ::: "memory")
#define PG8_WAIT_L(n) asm volatile("s_waitcnt lgkmcnt(" #n ")" ::: "memory")
#define PG8_BAR __builtin_amdgcn_s_barrier()
#define PG8_SCHED __builtin_amdgcn_sched_barrier(0)
    Unit cur, nxt; int ui = 0;
    if (!S.next(0, cur)) return;
    f32x4 acc[2][2][4][2];
#pragma unroll
    for (int a = 0; a < 2; ++a)
#pragma unroll
        for (int b = 0; b < 2; ++b)
#pragma unroll
            for (int m = 0; m < 4; ++m)
#pragma unroll
                for (int n = 0; n < 2; ++n) acc[a][b][m][n] = (f32x4){0.f, 0.f, 0.f, 0.f};
    bf16x8 At[4][2], B0[2][2], B1[2][2];
    const char* cA = (const char*)g.A + (size_t)cur.pm * tstep; const char* cB = (const char*)g.Bt + (size_t)cur.pn * tstep;
    S.a_ready(cur);
    if constexpr (SP2) {
        PG8_STAGE(PG8_SB(0, 0), cB, voffB); PG8_STAGE(PG8_SB(0, 1), cB + hstep, voffB); PG8_STAGE(PG8_SA(0, 0), cA, voffA); PG8_STAGE(PG8_SA(0, 1), cA + hstep, voffA);
        if (wr == 1) PG8_BAR;
        PG8_WAIT_V(2); PG8_BAR;
        PG8_STAGE(PG8_SB(1, 0), cB + kstep, voffB); PG8_STAGE(PG8_SA(1, 0), cA + kstep, voffA); PG8_STAGE(PG8_SB(1, 1), cB + hstep + kstep, voffB);
        PG8_WAIT_V(6); PG8_BAR;
    } else {
        PG8_STAGE(PG8_SB(0, 0), cB, voffB); PG8_STAGE(PG8_SA(0, 0), cA, voffA); PG8_STAGE(PG8_SB(0, 1), cB + hstep, voffB); PG8_STAGE(PG8_SA(0, 1), cA + hstep, voffA);
        if (wr == 1) PG8_BAR;
        PG8_WAIT_V(4); PG8_BAR;
        PG8_STAGE(PG8_SB(1, 0), cB + kstep, voffB); PG8_STAGE(PG8_SA(1, 0), cA + kstep, voffA); PG8_STAGE(PG8_SB(1, 1), cB + hstep + kstep, voffB);
        PG8_WAIT_V(6); PG8_BAR;
    }
    for (;;) {
        const bool has_next = S.next(ui + 1, nxt);
        const char* nA = has_next ? (const char*)g.A + (size_t)nxt.pm * tstep : cA; const char* nB = has_next ? (const char*)g.Bt + (size_t)nxt.pn * tstep : cB;
        for (int t = 0; t < nt; t += 2) {
            const bool last = (t == nt - 2);
            const char* a1 = cA + (size_t)(t + 1) * kstep;
            const char* a2 = last ? nA : cA + (size_t)(t + 2) * kstep; const char* b2 = last ? nB : cB + (size_t)(t + 2) * kstep;
            const char* a3 = a2 + kstep; const char* b3 = b2 + kstep;
            if (last && has_next) S.a_ready(nxt);
            if constexpr (SP2) {
            PG8_LDB(B0, 0, 0); PG8_LDB(B1, 0, 1); PG8_SCHED; PG8_LDA(At, 0, 0); PG8_STAGE(PG8_SA(1, 1), a1 + hstep, voffA);
            PG8_WAIT_V(8); PG8_WAIT_L(0); PG8_BAR; PG8_MMA(0, 0, At, B0); PG8_MMA(0, 1, At, B1); PG8_BAR; PG8_SCHED;
            PG8_LDA(At, 0, 1); PG8_STAGE(PG8_SB(0, 0), b2, voffB); PG8_STAGE(PG8_SB(0, 1), b2 + hstep, voffB); PG8_STAGE(PG8_SA(0, 0), a2, voffA);
            PG8_WAIT_V(8); PG8_WAIT_L(0); PG8_BAR; PG8_MMA(1, 0, At, B0); PG8_MMA(1, 1, At, B1); PG8_BAR; PG8_SCHED;
            PG8_LDB(B0, 1, 0); PG8_LDB(B1, 1, 1); PG8_SCHED; PG8_LDA(At, 1, 0); PG8_STAGE(PG8_SA(0, 1), a2 + hstep, voffA);
            PG8_WAIT_V(8); PG8_WAIT_L(0); PG8_BAR; PG8_MMA(0, 0, At, B0); PG8_MMA(0, 1, At, B1); PG8_BAR; PG8_SCHED;
            PG8_LDA(At, 1, 1); PG8_STAGE(PG8_SB(1, 0), b3, voffB); PG8_STAGE(PG8_SB(1, 1), b3 + hstep, voffB); PG8_STAGE(PG8_SA(1, 0), a3, voffA);
            PG8_WAIT_V(8); PG8_WAIT_L(0); PG8_BAR; PG8_MMA(1, 0, At, B0); PG8_MMA(1, 1, At, B1); PG8_BAR; PG8_SCHED;
            } else {
            PG8_LDB(B0, 0, 0); PG8_SCHED; PG8_LDA(At, 0, 0); PG8_STAGE(PG8_SA(1, 1), a1 + hstep, voffA);
            PG8_WAIT_L(8); PG8_BAR; PG8_WAIT_L(0); PG8_MMA(0, 0, At, B0); PG8_BAR; PG8_SCHED;
            PG8_LDB(B1, 0, 1); PG8_STAGE(PG8_SB(0, 0), b2, voffB);
            PG8_BAR; PG8_WAIT_L(0); PG8_MMA(0, 1, At, B1); PG8_BAR;
            PG8_LDA(At, 0, 1); PG8_STAGE(PG8_SA(0, 0), a2, voffA);
            PG8_BAR; PG8_WAIT_L(0); PG8_MMA(1, 0, At, B0); PG8_BAR; PG8_SCHED;
            PG8_STAGE(PG8_SB(0, 1), b2 + hstep, voffB);
            PG8_WAIT_V(6); PG8_BAR; PG8_MMA(1, 1, At, B1); PG8_BAR;
            PG8_LDB(B0, 1, 0); PG8_SCHED; PG8_LDA(At, 1, 0); PG8_STAGE(PG8_SA(0, 1), a2 + hstep, voffA);
            PG8_WAIT_L(8); PG8_BAR; PG8_WAIT_L(0); PG8_MMA(0, 0, At, B0); PG8_BAR; PG8_SCHED;
            PG8_LDB(B1, 1, 1); PG8_STAGE(PG8_SB(1, 0), b3, voffB);
            PG8_BAR; PG8_WAIT_L(0); PG8_MMA(0, 1, At, B1); PG8_BAR;
            PG8_LDA(At, 1, 1); PG8_STAGE(PG8_SA(1, 0), a3, voffA);
            PG8_BAR; PG8_WAIT_L(0); PG8_MMA(1, 0, At, B0); PG8_BAR; PG8_SCHED;
            PG8_STAGE(PG8_SB(1, 1), b3 + hstep, voffB);
            PG8_WAIT_V(6); PG8_BAR; PG8_MMA(1, 1, At, B1); PG8_BAR;
            }
        }
        if constexpr (ALIGN_EPI) { if (wr == 0) PG8_BAR; }
        if constexpr (!Epi::AFTER_DRAIN) { E(acc, cur, wr, wc, fr, fq); S.done(cur); }
        if (!has_next) break;
#pragma unroll
        for (int a = 0; a < 2; ++a)
#pragma unroll
            for (int b = 0; b < 2; ++b)
#pragma unroll
                for (int m = 0; m < 4; ++m)
#pragma unroll
                    for (int n = 0; n < 2; ++n) acc[a][b][m][n] = (f32x4){0.f, 0.f, 0.f, 0.f};
        cur = nxt; cA = nA; cB = nB; ++ui;
        if constexpr (ALIGN_EPI) { if (wr == 1) PG8_BAR; }
    }
    PG8_WAIT_V(0);
    if constexpr (!ALIGN_EPI) { if (wr == 0) PG8_BAR; }
    PG8_BAR;
    if constexpr (Epi::AFTER_DRAIN) { E.fused(acc, cur, wr, wc, fr, fq, lds, wid, lane); S.done(cur); }
#undef PG8_SA
#undef PG8_SB
#undef PG8_STAGE
#undef PG8_LDA
#undef PG8_LDB
#undef PG8_MMA
#undef PG8_WAIT_V
#undef PG8_WAIT_L
#undef PG8_BAR
#undef PG8_SCHED
}
}

#define PG8_SP2 true
#ifndef REP_P1
#define REP_P1 1
#endif
#ifndef REP_P4
#define REP_P4 1
#endif
#ifndef REP_P0
#define REP_P0 1
#endif
#ifndef REP_P2A
#define REP_P2A 1
#endif
#ifndef REP_P2C
#define REP_P2C 1
#endif
#ifndef REP_CONV
#define REP_CONV 1
#endif
#define PG8_ALIGN true

constexpr int NWAVES = 8;
constexpr int D = 1024, SEQ = 4096, M = 16384, NIN = 3584, FF = 2816, NGU = 2 * FF;
constexpr float NORM_EPS = 1e-6f;
constexpr size_t MiB = 1u << 20;
constexpr size_t WS_CTL = 0, CTL_ZERO_BYTES = 128 * 1024;
constexpr int CW_BAR = 16384;
constexpr size_t WS_WIN = 2 * MiB, WS_WO = 9 * MiB, WS_WGU = 11 * MiB, WS_WD = 22 * MiB;
constexpr size_t WS_COS = 28 * MiB, WS_SIN = 29 * MiB;
constexpr size_t WS_A = 32 * MiB;
constexpr size_t WS_B = 64 * MiB;
constexpr size_t WS_P = 96 * MiB;
constexpr size_t WS_END = 208 * MiB;
constexpr int LDS_BYTES = 131072 + 512;

#define LAS __attribute__((address_space(3)))
typedef unsigned short bf16;
typedef unsigned v4u __attribute__((ext_vector_type(4)));
typedef unsigned v2u __attribute__((ext_vector_type(2)));
typedef float f32x4 __attribute__((ext_vector_type(4)));
typedef short bf16x8 __attribute__((ext_vector_type(8)));
#define LDS_WAIT() asm volatile("s_waitcnt lgkmcnt(0)" ::: "memory")
__device__ __forceinline__ unsigned pk2(float lo, float hi) { return pg8::cvt_pk_bf16(lo, hi); }
__device__ __forceinline__ float bflo(unsigned u) { return __uint_as_float(u << 16); }
__device__ __forceinline__ float bfhi(unsigned u) { return __uint_as_float(u & 0xffff0000u); }
__device__ __forceinline__ float wave_sum(float v) {
#pragma unroll
    for (int o = 1; o < 64; o <<= 1) v += __shfl_xor(v, o);
    return v;
}
__device__ __forceinline__ float log2_gamma(int h) { return h == 0 ? -0.04580368961312479f : h == 1 ? -0.02272007650008353f : h == 2 ? -0.011315313227834146f : -0.005646563141142063f; }

#define XB_TMO      128
#define XB_XCNT(j)  (256  + 64 * (j))
#define XB_XSUB(j)  (1280 + 64 * (j))
#define XB_XGEN(j)  (2304 + 64 * (j))
#define XB_TOP      3328
#define XB_TOPGEN   3392
#define XCD_BAR_WORDS 3456
#define XB_SPIN_CAP (1u << 18)

__device__ __forceinline__ unsigned xb_ld(unsigned* p)              { return __hip_atomic_load(p, __ATOMIC_RELAXED, __HIP_MEMORY_SCOPE_AGENT); }
__device__ __forceinline__ unsigned xb_add(unsigned* p, unsigned v) { return __hip_atomic_fetch_add(p, v, __ATOMIC_RELAXED, __HIP_MEMORY_SCOPE_AGENT); }
__device__ __forceinline__ unsigned xb_xcc_id() { return (unsigned)__builtin_amdgcn_s_getreg((3 << 11) | 20) & 0xFu; }
#define XB_SPIN(cond, bar) do { unsigned _sp = 0; while (cond) { __builtin_amdgcn_s_sleep(1); \
    if ((++_sp & 255u) == 0u) { if (xb_ld(&(bar)[XB_TMO])) break; if (_sp > XB_SPIN_CAP) { atomicAdd(&(bar)[XB_TMO], 1u); break; } } } } while (0)

struct XcdBarrier {
    unsigned* bar; unsigned x;
    volatile LAS unsigned* st;
};

__device__ __forceinline__ XcdBarrier xcd_barrier_post(unsigned* bar, volatile LAS unsigned* st) {
    XcdBarrier b; b.bar = bar; b.x = xb_xcc_id(); b.st = st;
    if (threadIdx.x == 0) (void)xb_add(&bar[XB_XCNT(b.x)], 1u);
    return b;
}
__device__ __forceinline__ void xcd_barrier_complete(unsigned* bar, unsigned x, unsigned& nloc, unsigned& nx) {
    const unsigned G = gridDim.x * gridDim.y * gridDim.z;
    unsigned sum, cnt, mine, sp = 0u;
    for (;;) {
        sum = 0u; cnt = 0u; mine = 0u;
#pragma unroll
        for (unsigned j = 0; j < 16; ++j) { const unsigned c = xb_ld(&bar[XB_XCNT(j)]); sum += c; cnt += (c > 0u) ? 1u : 0u; mine = (j == x) ? c : mine; }
        if (sum == G) break;
        __builtin_amdgcn_s_sleep(1);
        if ((++sp & 255u) == 0u) { if (xb_ld(&bar[XB_TMO])) break; if (sp > XB_SPIN_CAP) { atomicAdd(&bar[XB_TMO], 1u); break; } }
    }
    nloc = mine > 0u ? mine : 1u; nx = cnt > 0u ? cnt : 1u;
}

__device__ __forceinline__ void xcd_barrier(const XcdBarrier& b) {
    asm volatile("s_waitcnt vmcnt(0)" ::: "memory");
    __syncthreads();
    if (threadIdx.x == 0) {
        unsigned* bar = b.bar;
        __builtin_amdgcn_s_waitcnt(0);
        unsigned nloc = b.st[0], nx = b.st[1];
        if (nloc == 0u) { xcd_barrier_complete(bar, b.x, nloc, nx); b.st[0] = nloc; b.st[1] = nx; }
        const unsigned old = xb_add(&bar[XB_XSUB(b.x)], 1u);
        const unsigned gen = old / nloc;
        if (old + 1u == (gen + 1u) * nloc) {
            __builtin_amdgcn_fence(__ATOMIC_RELEASE, "agent");
            asm volatile("s_waitcnt vmcnt(0)" ::: "memory");
            const unsigned og = xb_add(&bar[XB_TOP], 1u);
            const unsigned tg = og / nx;
            if (og + 1u == (tg + 1u) * nx) xb_add(&bar[XB_TOPGEN], 1u);
            else XB_SPIN(xb_ld(&bar[XB_TOPGEN]) == tg, bar);
            __builtin_amdgcn_fence(__ATOMIC_ACQUIRE, "agent");
            xb_add(&bar[XB_XGEN(b.x)], 1u);
            asm volatile("s_waitcnt vmcnt(0)" ::: "memory");
        } else {
            XB_SPIN(xb_ld(&bar[XB_XGEN(b.x)]) == gen, bar);
            __builtin_amdgcn_fence(__ATOMIC_ACQUIRE, "agent");
            asm volatile("s_waitcnt vmcnt(0)" ::: "memory");
        }
    }
    __syncthreads();
}

struct Frame {
    LAS unsigned char* lds;
    int tid, lane, wave, G, gw, NGW;
};

__device__ __forceinline__ void p0_tr(const float* W, int K, int N, bf16* WT, int k0, int n0, int dst0, const float* ks, LAS float* scr, int lane) {
#pragma unroll 8
    for (int i = 0; i < 32; ++i) { const int kk = 2 * i + (lane >> 5); float v = W[(size_t)(k0 + kk) * N + n0 + (lane & 31)]; if (ks) v *= ks[k0 + kk]; scr[kk * 33 + (lane & 31)] = v; }
    LDS_WAIT(); asm volatile("" ::: "memory");
    const int c = lane & 7;
#pragma unroll
    for (int j = 0; j < 4; ++j) { const int n = (lane >> 3) + 8 * j; const LAS float* s = scr + (8 * c) * 33 + n;
        v4u o; o.x = pk2(s[0 * 33], s[1 * 33]); o.y = pk2(s[2 * 33], s[3 * 33]); o.z = pk2(s[4 * 33], s[5 * 33]); o.w = pk2(s[6 * 33], s[7 * 33]);
        *(v4u*)(WT + (size_t)(dst0 + n) * K + k0 + 8 * c) = o; }
    LDS_WAIT(); asm volatile("" ::: "memory");
}
__device__ __forceinline__ void p0_prologue(const Frame& F, const float* x, const float* g1, const float* w_in, const float* w_o, const float* g2, const float* w_gate, const float* w_up, const float* w_down,
                                            bf16* Win_t, bf16* Wo_t, bf16* Wgu_t, bf16* Wd_t, float* costab, float* sintab, bf16* XN) {
    LAS float* scr = (LAS float*)(F.lds + F.wave * 16384);
    constexpr int I_IN = 16 * 112, I_O = 16 * 32, I_G = 16 * 88, I_D = 44 * 32, NITEMS = I_IN + I_O + 2 * I_G + I_D;
    for (int it = F.gw; it < NITEMS; it += F.NGW) {
        int r = it;
        if (r < I_IN) { const int kb = r / 112, nb = r % 112, n0 = 32 * nb; int dst = n0;
            if (n0 < 1024) { const int s = n0 & 255; dst = (n0 & ~255) + ((s >> 6) & 1) * 128 + (s >> 7) * 64 + (s & 63); }
            p0_tr(w_in, 1024, NIN, Win_t, 64 * kb, n0, dst, nullptr, scr, F.lane); continue; } r -= I_IN;
        if (r < I_O) { const int kb = r / 32, nb = r % 32; p0_tr(w_o, 1024, 1024, Wo_t, 64 * kb, 32 * nb, 32 * nb, nullptr, scr, F.lane); continue; } r -= I_O;
        if (r < I_G) { const int kb = r / 88, nb = r % 88, n0 = 32 * nb; p0_tr(w_gate, 1024, FF, Wgu_t, 64 * kb, n0, 256 * (n0 >> 7) + (n0 & 127), g2, scr, F.lane); continue; } r -= I_G;
        if (r < I_G) { const int kb = r / 88, nb = r % 88, n0 = 32 * nb; p0_tr(w_up, 1024, FF, Wgu_t, 64 * kb, n0, 256 * (n0 >> 7) + 128 + (n0 & 127), g2, scr, F.lane); continue; } r -= I_G;
        { const int kb = r / 32, nb = r % 32; p0_tr(w_down, FF, 1024, Wd_t, 64 * kb, 32 * nb, 32 * nb, nullptr, scr, F.lane); }
    }
    for (int idx = F.gw * 64 + F.lane; idx < SEQ * 64; idx += F.NGW * 64) {
        const int pos = idx >> 6, i = idx & 63;
        double f = 1.0;
        if (i & 1) f *= 0.8659643233600653; if (i & 2) f *= 0.7498942093324558; if (i & 4) f *= 0.5623413251903491;
        if (i & 8) f *= 0.31622776601683794; if (i & 16) f *= 0.09999999999999999; if (i & 32) f *= 0.009999999999999998;
        const double ang = (double)pos * f;
        const double q = __builtin_rint(ang * 0.6366197723675814);
        double s = __builtin_fma(-q, 1.5707963267948966, ang); s = __builtin_fma(-q, 6.123233995736766e-17, s);
        const double s2 = s * s;
        double sn = 1.0 / 6227020800.0; sn = sn * s2 - 1.0 / 39916800.0; sn = sn * s2 + 1.0 / 362880.0; sn = sn * s2 - 1.0 / 5040.0; sn = sn * s2 + 1.0 / 120.0; sn = sn * s2 - 1.0 / 6.0; sn = sn * s2 + 1.0; sn *= s;
        double cn = -1.0 / 87178291200.0; cn = cn * s2 + 1.0 / 479001600.0; cn = cn * s2 - 1.0 / 3628800.0; cn = cn * s2 + 1.0 / 40320.0; cn = cn * s2 - 1.0 / 720.0; cn = cn * s2 + 1.0 / 24.0; cn = cn * s2 - 0.5; cn = cn * s2 + 1.0;
        const int qi = (int)q & 3;
        const double sv = (qi == 0) ? sn : (qi == 1) ? cn : (qi == 2) ? -sn : -cn;
        const double cv = (qi == 0) ? cn : (qi == 1) ? -sn : (qi == 2) ? -cn : sn;
        costab[idx] = (float)cv; sintab[idx] = (float)sv;
    }
    for (int m = F.gw; m < M; m += F.NGW) {
        const f32x4* xr = (const f32x4*)(x + (size_t)m * D) + F.lane; const f32x4* gr = (const f32x4*)g1 + F.lane;
        f32x4 v[4]; float s = 0.f;
#pragma unroll
        for (int j = 0; j < 4; ++j) { v[j] = xr[64 * j]; s += (v[j].x * v[j].x + v[j].y * v[j].y) + (v[j].z * v[j].z + v[j].w * v[j].w); }
        const float rstd = __builtin_amdgcn_rsqf(wave_sum(s) * (1.f / D) + NORM_EPS);
        v2u* o8 = (v2u*)(XN + (size_t)m * D) + F.lane;
#pragma unroll
        for (int j = 0; j < 4; ++j) { const f32x4 g = gr[64 * j]; v2u o; o.x = pk2(v[j].x * rstd * g.x, v[j].y * rstd * g.y); o.y = pk2(v[j].z * rstd * g.z, v[j].w * rstd * g.w); o8[64 * j] = o; }
    }
}

__device__ __forceinline__ void p2a_item(const Frame& F, const bf16* PROJ, bf16* ST, int item) {
    const int tid = F.tid, lane = F.lane, w = F.wave, fr = lane & 15, fq = lane >> 4;
    const int h = item & 3, n = (item >> 2) & 63, b = item >> 8, bh = b * 4 + h;
    const size_t tok0 = (size_t)b * SEQ + n * 64;
    const int kc0 = 512 + 256 * (h >> 1) + 64 * (h & 1), vc0 = 1024 + h * 128;
    LAS bf16* KT = (LAS bf16*)F.lds;
    LAS bf16* VT = KT + 128 * 72;
    const float l2g = log2_gamma(h);
#pragma unroll
    for (int i = 0; i < 2; ++i) { const int c = tid + 512 * i, j = c >> 4, cc = c & 15;
        const bf16* rp = PROJ + (tok0 + j) * NIN;
        const v4u kv = *(const v4u*)(rp + kc0 + (cc & 7) * 8 + (cc >> 3) * 128);
        const v4u vv = *(const v4u*)(rp + vc0 + cc * 8);
        const float zeta = __builtin_amdgcn_exp2f(l2g * (float)(63 - j));
        LAS bf16* kd = KT + (cc * 8) * 72 + j; LAS bf16* vd = VT + (cc * 8) * 72 + j;
#pragma unroll
        for (int q = 0; q < 4; ++q) { const unsigned ku = kv[q], vu = vv[q];
            kd[(2 * q) * 72] = (bf16)(ku & 0xffffu); kd[(2 * q + 1) * 72] = (bf16)(ku >> 16);
            const unsigned p = pk2(bflo(vu) * zeta, bfhi(vu) * zeta);
            vd[(2 * q) * 72] = (bf16)(p & 0xffffu); vd[(2 * q + 1) * 72] = (bf16)(p >> 16); } }
    __syncthreads();
    bf16x8 a[2];
#pragma unroll
    for (int kk = 0; kk < 2; ++kk) a[kk] = *(const LAS bf16x8*)(KT + (w * 16 + fr) * 72 + kk * 32 + fq * 8);
    bf16* dst = ST + ((size_t)(bh * 64 + n) * 128) * 128 + w * 16 + 4 * fq;
#pragma unroll
    for (int et = 0; et < 8; ++et) {
        f32x4 acc = (f32x4){0.f, 0.f, 0.f, 0.f};
#pragma unroll
        for (int kk = 0; kk < 2; ++kk) { const bf16x8 bb = *(const LAS bf16x8*)(VT + (et * 16 + fr) * 72 + kk * 32 + fq * 8); acc = __builtin_amdgcn_mfma_f32_16x16x32_bf16(a[kk], bb, acc, 0, 0, 0); }
        v2u o; o.x = pk2(acc[0], acc[1]); o.y = pk2(acc[2], acc[3]);
        *(v2u*)(dst + (size_t)(et * 16 + fr) * 128) = o;
    }
    __syncthreads();
}
__device__ __forceinline__ void p2b_scan(const Frame& F, bf16* ST) {
    for (int p = blockIdx.x * 512 + F.tid; p < 16 * 8192; p += F.G * 512) {
        const int bh = p >> 13, off = (p & 8191) * 2;
        const float cd = __builtin_amdgcn_exp2f(64.f * log2_gamma(bh & 3));
        unsigned* base = (unsigned*)(ST + (size_t)bh * 64 * 16384 + off);
        float s0 = 0.f, s1 = 0.f;
#pragma unroll 8
        for (int n = 0; n < 64; ++n) { const unsigned v = base[(size_t)n * 8192]; base[(size_t)n * 8192] = pk2(s0, s1); s0 = cd * s0 + bflo(v); s1 = cd * s1 + bfhi(v); }
    }
}
constexpr int QS_OFF = 0, KS_OFF = 17408, VT_OFF = 34816, ST_OFF = 53248, SB_OFF = 88064, RED_OFF = 97280;
__device__ __forceinline__ void p2c_item(const Frame& F, const bf16* PROJ, const bf16* ST, const float* gnw, bf16* MIX, int item) {
    const int tid = F.tid, lane = F.lane, w = F.wave, fr = lane & 15, fq = lane >> 4;
    const int h = item & 3, n = (item >> 2) & 63, b = item >> 8, bh = b * 4 + h;
    const size_t tok0 = (size_t)b * SEQ + n * 64;
    const int qc0 = 256 * (h >> 1) + 64 * (h & 1), vc0 = 1024 + h * 128;
    LAS bf16* Qs = (LAS bf16*)(F.lds + QS_OFF);
    LAS bf16* Ks = (LAS bf16*)(F.lds + KS_OFF);
    LAS bf16* VT = (LAS bf16*)(F.lds + VT_OFF);
    LAS bf16* Ss = (LAS bf16*)(F.lds + ST_OFF);
    LAS bf16* Sb = (LAS bf16*)(F.lds + SB_OFF);
    LAS float* red = (LAS float*)(F.lds + RED_OFF);
    const float l2g = log2_gamma(h);
#pragma unroll
    for (int i = 0; i < 2; ++i) { const int c = tid + 512 * i, j = c >> 4, cc = c & 15;
        const bf16* rp = PROJ + (tok0 + j) * NIN; const int qcol = qc0 + (cc & 7) * 8 + (cc >> 3) * 128;
        const v4u qv = *(const v4u*)(rp + qcol), kv = *(const v4u*)(rp + 512 + qcol), vv = *(const v4u*)(rp + vc0 + cc * 8);
        *(LAS v4u*)(Qs + j * 136 + cc * 8) = qv; *(LAS v4u*)(Ks + j * 136 + cc * 8) = kv;
        LAS bf16* vd = VT + (cc * 8) * 72 + j;
#pragma unroll
        for (int q = 0; q < 4; ++q) { const unsigned vu = vv[q]; vd[(2 * q) * 72] = (bf16)(vu & 0xffffu); vd[(2 * q + 1) * 72] = (bf16)(vu >> 16); } }
    { const bf16* sp = ST + ((size_t)(bh * 64 + n) * 128) * 128;
#pragma unroll
      for (int i = 0; i < 4; ++i) { const int c = tid + 512 * i, e = c >> 4, cc = c & 15; *(LAS v4u*)(Ss + e * 136 + cc * 8) = *(const v4u*)(sp + e * 128 + cc * 8); } }
    __syncthreads();
    const int rb = w >> 1, half = w & 1, irow = rb * 16 + fr;
    bf16x8 qf[4];
#pragma unroll
    for (int kk = 0; kk < 4; ++kk) qf[kk] = *(const LAS bf16x8*)(Qs + irow * 136 + kk * 32 + fq * 8);
#pragma unroll
    for (int jj = 0; jj < 2; ++jj) { const int jt = half * 2 + jj;
        f32x4 acc = (f32x4){0.f, 0.f, 0.f, 0.f};
#pragma unroll
        for (int kk = 0; kk < 4; ++kk) { const bf16x8 kf = *(const LAS bf16x8*)(Ks + (jt * 16 + fr) * 136 + kk * 32 + fq * 8); acc = __builtin_amdgcn_mfma_f32_16x16x32_bf16(kf, qf[kk], acc, 0, 0, 0); }
        float o[4];
#pragma unroll
        for (int t = 0; t < 4; ++t) { const int dj = irow - (jt * 16 + 4 * fq + t); o[t] = acc[t] * __builtin_amdgcn_exp2f(l2g * (float)(dj < 0 ? -dj : dj)); }
        v2u pkd; pkd.x = pk2(o[0], o[1]); pkd.y = pk2(o[2], o[3]);
        *(LAS v2u*)(Sb + irow * 72 + jt * 16 + 4 * fq) = pkd; }
    __syncthreads();
    bf16x8 sf[2];
#pragma unroll
    for (int kk = 0; kk < 2; ++kk) sf[kk] = *(const LAS bf16x8*)(Sb + irow * 72 + kk * 32 + fq * 8);
    const float xi = __builtin_amdgcn_exp2f(l2g * (float)(irow + 1));
    f32x4 o[4]; float ss = 0.f;
#pragma unroll
    for (int ct = 0; ct < 4; ++ct) { const int e0 = half * 64 + ct * 16;
        f32x4 ai = (f32x4){0.f, 0.f, 0.f, 0.f}, ac = (f32x4){0.f, 0.f, 0.f, 0.f};
#pragma unroll
        for (int kk = 0; kk < 2; ++kk) { const bf16x8 vf = *(const LAS bf16x8*)(VT + (e0 + fr) * 72 + kk * 32 + fq * 8); ai = __builtin_amdgcn_mfma_f32_16x16x32_bf16(vf, sf[kk], ai, 0, 0, 0); }
#pragma unroll
        for (int kk = 0; kk < 4; ++kk) { const bf16x8 tf = *(const LAS bf16x8*)(Ss + (e0 + fr) * 136 + kk * 32 + fq * 8); ac = __builtin_amdgcn_mfma_f32_16x16x32_bf16(tf, qf[kk], ac, 0, 0, 0); }
        o[ct] = ai + ac * xi;
        ss += (o[ct][0] * o[ct][0] + o[ct][1] * o[ct][1]) + (o[ct][2] * o[ct][2] + o[ct][3] * o[ct][3]); }
    ss += __shfl_xor(ss, 16); ss += __shfl_xor(ss, 32);
    if (fq == 0) red[w * 16 + fr] = ss;
    __syncthreads();
    const float tot = red[(rb * 2) * 16 + fr] + red[(rb * 2 + 1) * 16 + fr];
    const float rstd = __builtin_amdgcn_rsqf(tot * (1.0f / 128.0f) + NORM_EPS);
    const size_t trow = tok0 + irow;
#pragma unroll
    for (int ct = 0; ct < 4; ++ct) { const int e = half * 64 + ct * 16 + 4 * fq;
        const f32x4 gw = *(const f32x4*)(gnw + h * 128 + e);
        const v2u gu = *(const v2u*)(PROJ + trow * NIN + 1536 + h * 128 + e);
        float g[4] = {bflo(gu.x), bfhi(gu.x), bflo(gu.y), bfhi(gu.y)}; float r[4];
#pragma unroll
        for (int t = 0; t < 4; ++t) r[t] = o[ct][t] * rstd * gw[t] * (g[t] * __builtin_amdgcn_rcpf(1.0f + __builtin_amdgcn_exp2f(g[t] * -1.4426950408889634f)));
        v2u pkd; pkd.x = pk2(r[0], r[1]); pkd.y = pk2(r[2], r[3]);
        *(v2u*)(MIX + trow * 1024 + h * 128 + e) = pkd; }
}
__device__ __forceinline__ void p2c_conv(const Frame& F, const bf16* PROJ, const float* wconv, bf16* MIX) {
    for (int id = blockIdx.x * 512 + F.tid; id < (M / 8) * 64; id += F.G * 512) {
        const int cv = id & 63, tg = id >> 6, c0 = cv * 8, t0 = tg * 8;
        float w0[8], w1[8], w2[8];
#pragma unroll
        for (int q = 0; q < 2; ++q) { const f32x4 a = *(const f32x4*)(wconv + c0 + 4 * q), bq = *(const f32x4*)(wconv + 512 + c0 + 4 * q), cq = *(const f32x4*)(wconv + 1024 + c0 + 4 * q);
#pragma unroll
            for (int t = 0; t < 4; ++t) { w0[4 * q + t] = a[t]; w1[4 * q + t] = bq[t]; w2[4 * q + t] = cq[t]; } }
        float u2[8], u1[8];
        const bool first = (t0 & (SEQ - 1)) == 0;
#pragma unroll
        for (int r = 0; r < 2; ++r) { float* up = r == 0 ? u2 : u1;
            if (first) {
#pragma unroll
                for (int q = 0; q < 8; ++q) up[q] = 0.f;
            } else { const bf16* rp = PROJ + (size_t)(t0 - 2 + r) * NIN; const v4u cc = *(const v4u*)(rp + 2560 + c0), ch = *(const v4u*)(rp + 3072 + c0);
#pragma unroll
                for (int q = 0; q < 4; ++q) { up[2 * q] = bflo(cc[q]) * bflo(ch[q]); up[2 * q + 1] = bfhi(cc[q]) * bfhi(ch[q]); } } }
#pragma unroll
        for (int t = 0; t < 8; ++t) { const bf16* rp = PROJ + (size_t)(t0 + t) * NIN;
            const v4u cb = *(const v4u*)(rp + 2048 + c0), cc = *(const v4u*)(rp + 2560 + c0), ch = *(const v4u*)(rp + 3072 + c0);
            float u0[8], o[8];
#pragma unroll
            for (int q = 0; q < 4; ++q) { u0[2 * q] = bflo(cc[q]) * bflo(ch[q]); u0[2 * q + 1] = bfhi(cc[q]) * bfhi(ch[q]); }
#pragma unroll
            for (int q = 0; q < 4; ++q) { o[2 * q] = bflo(cb[q]) * (w0[2 * q] * u2[2 * q] + w1[2 * q] * u1[2 * q] + w2[2 * q] * u0[2 * q]);
                o[2 * q + 1] = bfhi(cb[q]) * (w0[2 * q + 1] * u2[2 * q + 1] + w1[2 * q + 1] * u1[2 * q + 1] + w2[2 * q + 1] * u0[2 * q + 1]); }
            v4u pkd; pkd.x = pk2(o[0], o[1]); pkd.y = pk2(o[2], o[3]); pkd.z = pk2(o[4], o[5]); pkd.w = pk2(o[6], o[7]);
            *(v4u*)(MIX + (size_t)(t0 + t) * 1024 + 512 + c0) = pkd;
#pragma unroll
            for (int q = 0; q < 8; ++q) { u2[q] = u1[q]; u1[q] = u0[q]; } }
    }
}

struct Args { const float* in[11]; float* out; unsigned char* ws; };
__global__ void __launch_bounds__(NWAVES * 64, 2) mk_fwd(Args args) {
    extern __shared__ __attribute__((aligned(16))) unsigned char lds[];
    Frame F;
    F.lds = (LAS unsigned char*)lds;
    F.tid = threadIdx.x; F.lane = F.tid & 63; F.wave = __builtin_amdgcn_readfirstlane(F.tid >> 6);
    F.G = gridDim.x; F.gw = blockIdx.x * NWAVES + F.wave; F.NGW = F.G * NWAVES;
    unsigned char* ws = args.ws;
    const float* x = args.in[0]; const float* norm1_w = args.in[1]; const float* w_in = args.in[2]; const float* w_conv = args.in[3]; const float* gn_w = args.in[4];
    const float* w_o = args.in[5]; const float* norm2_w = args.in[6]; const float* w_gate = args.in[7]; const float* w_up = args.in[8]; const float* w_down = args.in[9]; const float* fin_w = args.in[10];
    float* out = args.out;
    float* rowss = (float*)(ws + WS_CTL);
    bf16* Win_t = (bf16*)(ws + WS_WIN); bf16* Wo_t = (bf16*)(ws + WS_WO); bf16* Wgu_t = (bf16*)(ws + WS_WGU); bf16* Wd_t = (bf16*)(ws + WS_WD);
    float* costab = (float*)(ws + WS_COS); float* sintab = (float*)(ws + WS_SIN);
    bf16* XN = (bf16*)(ws + WS_A); bf16* MIX = (bf16*)(ws + WS_A);
    bf16* ST = (bf16*)(ws + WS_B); bf16* X1B = (bf16*)(ws + WS_B);
    bf16* PROJ = (bf16*)(ws + WS_P); bf16* HB = (bf16*)(ws + WS_P);

    if (F.tid < 16) ((volatile LAS unsigned*)(F.lds + 131072))[F.tid] = 0u;
    __syncthreads();
    XcdBarrier bar = xcd_barrier_post((unsigned*)(ws + WS_CTL) + CW_BAR, (volatile LAS unsigned*)(F.lds + 131072) + 8);
#define GSYNC() xcd_barrier(bar)
    for (int rep = 0; rep < REP_P0; ++rep)
    p0_prologue(F, x, norm1_w, w_in, w_o, norm2_w, w_gate, w_up, w_down, Win_t, Wo_t, Wgu_t, Wd_t, costab, sintab, XN);
    GSYNC();
    { pg8::Gemm g{XN, Win_t, M, NIN, D}; pg8::StaticOrder S; S.init(M, NIN, F.G, (int)blockIdx.x);
      pg8::EpiProj E{PROJ, costab, sintab};
      pg8::gemm_phase<pg8::EpiProj, pg8::StaticOrder, PG8_ALIGN, PG8_SP2>(F.lds, g, S, E); }
#if REP_P1 > 1
    __syncthreads();
    { pg8::Gemm g{XN, Win_t, M, NIN, D}; pg8::StaticOrder S; S.init(M, NIN, F.G, (int)blockIdx.x);
      pg8::EpiProj E{PROJ, costab, sintab};
      pg8::gemm_phase<pg8::EpiProj, pg8::StaticOrder, PG8_ALIGN, PG8_SP2>(F.lds, g, S, E); }
#endif
    GSYNC();
#ifdef DBG_AFTER_P1
    for (int m = F.gw; m < M; m += F.NGW) { const bf16* pr = PROJ + (size_t)m * NIN;
        for (int c = F.lane; c < 1024; c += 64) { float v = bflo(pr[c]) + bflo(pr[c + 1024]) + bflo(pr[c + 2048]) + (c < 512 ? bflo(pr[c + 3072]) : 0.f); out[(size_t)m * D + c] = v; } }
    return;
#endif
    for (int rep = 0; rep < REP_P2A; ++rep)
    for (int it = blockIdx.x; it < 1024; it += F.G) p2a_item(F, PROJ, ST, it);
    GSYNC();
#ifdef DBG_AFTER_P2A
    for (int m = F.gw; m < M; m += F.NGW) { const bf16* pr = ST + (size_t)m * 1024;
        for (int c = F.lane; c < 1024; c += 64) out[(size_t)m * D + c] = bflo(pr[c]); }
    return;
#endif
    p2b_scan(F, ST);
    GSYNC();
#ifdef DBG_AFTER_P2B
    for (int m = F.gw; m < M; m += F.NGW) { const bf16* pr = ST + (size_t)m * 1024;
        for (int c = F.lane; c < 1024; c += 64) out[(size_t)m * D + c] = bflo(pr[c]); }
    return;
#endif
    for (int rep = 0; rep < REP_P2C; ++rep)
    for (int it = blockIdx.x; it < 1024; it += F.G) p2c_item(F, PROJ, ST, gn_w, MIX, it);
    for (int rep = 0; rep < REP_CONV; ++rep)
    p2c_conv(F, PROJ, w_conv, MIX);
    GSYNC();
#ifdef DBG_AFTER_P2C
    for (int m = F.gw; m < M; m += F.NGW) { const bf16* pr = MIX + (size_t)m * 1024;
        for (int c = F.lane; c < 1024; c += 64) out[(size_t)m * D + c] = bflo(pr[c]); }
    return;
#endif
    { pg8::Gemm g{MIX, Wo_t, M, D, D}; pg8::StaticOrder S; S.init(M, D, F.G, (int)blockIdx.x);
      pg8::EpiRes1 E{x, out, X1B, rowss};
      pg8::gemm_phase<pg8::EpiRes1, pg8::StaticOrder, PG8_ALIGN, PG8_SP2>(F.lds, g, S, E); }
    GSYNC();
    { pg8::Gemm g{X1B, Wgu_t, M, NGU, D}; pg8::StaticOrder S; S.init(M, NGU, F.G, (int)blockIdx.x);
      pg8::EpiGU E{HB, rowss};
      pg8::gemm_phase<pg8::EpiGU, pg8::StaticOrder, PG8_ALIGN, PG8_SP2>(F.lds, g, S, E); }
#if REP_P4 > 1
    __syncthreads();
    { pg8::Gemm g{X1B, Wgu_t, M, NGU, D}; pg8::StaticOrder S; S.init(M, NGU, F.G, (int)blockIdx.x);
      pg8::EpiGU E{HB, rowss};
      pg8::gemm_phase<pg8::EpiGU, pg8::StaticOrder, PG8_ALIGN, PG8_SP2>(F.lds, g, S, E); }
#endif
    GSYNC();
    { pg8::Gemm g{HB, Wd_t, M, D, FF}; pg8::StaticOrder S; S.init(M, D, F.G, (int)blockIdx.x);
      pg8::EpiRes2 E{out};
      pg8::gemm_phase<pg8::EpiRes2, pg8::StaticOrder, PG8_ALIGN, PG8_SP2>(F.lds, g, S, E); }
    GSYNC();
    for (int m = F.gw; m < M; m += F.NGW) {
        f32x4* xr = (f32x4*)(out + (size_t)m * D) + F.lane; const f32x4* gr = (const f32x4*)fin_w + F.lane;
        f32x4 v[4]; float s = 0.f;
#pragma unroll
        for (int j = 0; j < 4; ++j) { v[j] = xr[64 * j]; s += (v[j].x * v[j].x + v[j].y * v[j].y) + (v[j].z * v[j].z + v[j].w * v[j].w); }
        const float rstd = __builtin_amdgcn_rsqf(wave_sum(s) * (1.f / D) + NORM_EPS);
#pragma unroll
        for (int j = 0; j < 4; ++j) { const f32x4 g = gr[64 * j]; xr[64 * j] = v[j] * rstd * g; }
    }
}

extern "C" void kernel_launch(void* const* d_in, const int* in_sizes, int n_in, void* d_out, int out_size, void* d_ws, size_t ws_size, hipStream_t stream) {
    static int grid = 0;
    if (grid == 0) {
        if (n_in != 11 || out_size != M * D || ws_size < WS_END) { fprintf(stderr, "kernel_launch: unexpected shapes (n_in %d out %d ws %zu)\n", n_in, out_size, ws_size); grid = -1; return; }
        int dev = 0, cus = 0, per_cu = 0;
        hipGetDevice(&dev);
        hipDeviceGetAttribute(&cus, hipDeviceAttributeMultiprocessorCount, dev);
        if (hipFuncSetAttribute((const void*)mk_fwd, hipFuncAttributeMaxDynamicSharedMemorySize, LDS_BYTES) != hipSuccess) { fprintf(stderr, "kernel_launch: hipFuncSetAttribute failed\n"); grid = -1; return; }
        if (hipOccupancyMaxActiveBlocksPerMultiprocessor(&per_cu, (const void*)mk_fwd, NWAVES * 64, LDS_BYTES) != hipSuccess || per_cu < 1) { fprintf(stderr, "kernel_launch: occupancy query failed (%d)\n", per_cu); (void)hipGetLastError(); per_cu = 1; }
        if (per_cu > 1) per_cu = 1;
        grid = cus * per_cu;
    }
    if (grid < 0) return;
    (void)hipMemsetAsync((char*)d_ws + WS_CTL, 0, CTL_ZERO_BYTES, stream);
    Args a{};
    for (int i = 0; i < 11; ++i) a.in[i] = (const float*)d_in[i];
    a.out = (float*)d_out; a.ws = (unsigned char*)d_ws;
    void* kargs[] = {&a};
    hipError_t e = hipLaunchCooperativeKernel((const void*)mk_fwd, dim3(grid), dim3(NWAVES * 64), kargs, LDS_BYTES, stream);
    if (e != hipSuccess) fprintf(stderr, "kernel_launch: cooperative launch failed: %s (grid %d)\n", hipGetErrorString(e), grid);
}
```
